# Optimizing an MI355X kernel written in HIP

```python
import math
import jax
import jax.numpy as jnp
from jax import lax
import numpy as np

D_MODEL = 2048
BATCH = 32
SEQ = 256
DEPTH = 1
DEC_BATCH = 2
DEC_SEQ = 1024
PAST_LEN = 256

GRID_W = 64
D_HY = 1024
HY_ORDER = 2
HY_BANDS = 16
HY_EMB = 1 + 2 * HY_BANDS
HY_FILTER_HIDDEN = 64
HY_DECAY_FAST = 0.3
HY_DECAY_SLOW = 1.5
HY_DECAY_TARGET = 1e-2
N_RET_HEADS = 8
RET_HEAD_DIM = 128
D_RET = N_RET_HEADS * RET_HEAD_DIM
RET_CHUNK = 128
ROPE_BASE = 10000.0
ROPE_FREQS = RET_HEAD_DIM // 4
D_FF = 5632
N_IN = 3 * D_HY + 4 * D_RET + 2 * D_MODEL
RMS_EPS = 1e-6
GN_EPS = 1e-5
FILTER_EPS = 1e-6
F32 = jnp.float32

kernel_name = 'hybrid_hyena_retention_diffusion_step'


def rmsnorm(x, g):
    xf = x.astype(F32)
    y = xf * lax.rsqrt(jnp.mean(xf * xf, axis=-1, keepdims=True) + RMS_EPS)
    return (y * g.astype(F32)).astype(x.dtype)


def dwconv3(x, w):
    xp = jnp.pad(x, ((0, 0), (1, 1), (0, 0)))
    return xp[:, :-2] * w[0] + xp[:, 1:-1] * w[1] + xp[:, 2:] * w[2]


def rope_2d(L):
    ROWS = L // GRID_W
    row = jnp.repeat(jnp.arange(ROWS), GRID_W).astype(F32)
    col = jnp.tile(jnp.arange(GRID_W), ROWS).astype(F32)
    inv = ROPE_BASE ** (-jnp.arange(ROPE_FREQS, dtype=F32) / ROPE_FREQS)
    ang = jnp.concatenate([row[:, None] * inv, col[:, None] * inv], axis=-1)
    return jnp.cos(ang), jnp.sin(ang)


def apply_rope(x, cos, sin):
    half = x.shape[-1] // 2
    x1, x2 = x[..., :half], x[..., half:]
    c = cos[None, :, None, :]
    s = sin[None, :, None, :]
    return jnp.concatenate([x1 * c - x2 * s, x2 * c + x1 * s], axis=-1)


def hyena_filter_fft(L, w1, b1, w2, b2, w3, b3, freq, decay):
    n = jnp.arange(L, dtype=F32)
    t = n / L
    f = jnp.linspace(1e-4, HY_BANDS - 1, HY_BANDS, dtype=F32)
    w = 2.0 * math.pi * n / L
    z = jnp.concatenate([t[:, None], jnp.cos(w[:, None] * f), jnp.sin(w[:, None] * f)], axis=-1)
    fr = freq.astype(F32)
    h = jnp.sin(fr[0] * (z @ w1.astype(F32) + b1.astype(F32)))
    h = jnp.sin(fr[1] * (h @ w2.astype(F32) + b2.astype(F32)))
    h = (h @ w3.astype(F32) + b3.astype(F32)).reshape(L, 2, HY_ORDER, D_HY)
    h = h * jnp.exp(-t[:, None, None, None] * jnp.abs(decay.astype(F32))[None])
    h_fwd, h_bwd = h[:, 0], h[:, 1]
    k = jnp.concatenate([h_fwd, jnp.zeros((1, HY_ORDER, D_HY), F32), h_bwd[1:][::-1]], axis=0)
    k = k / (jnp.sum(jnp.abs(k), axis=0, keepdims=True) + FILTER_EPS)
    return jnp.fft.rfft(k, axis=0)


def fftconv(u, kf, bias):
    L = u.shape[1]
    uf = jnp.fft.rfft(u, n=2 * L, axis=1)
    y = jnp.fft.irfft(uf * kf[None], n=2 * L, axis=1)[:, :L]
    return y + u * bias


def ret_chunk_scan(q, k, v, gamma, state0):
    B, L, H, _ = q.shape
    DV = v.shape[-1]
    C = RET_CHUNK
    N = L // C
    log_g = jnp.log(gamma)
    idx = jnp.arange(C, dtype=F32)
    diff = idx[:, None] - idx[None, :]
    intra = jnp.where(diff[None] >= 0, jnp.exp(log_g[:, None, None] * jnp.maximum(diff, 0.0)[None]), 0.0)
    xi = jnp.exp(log_g[None, :] * (idx[:, None] + 1.0))
    zeta = jnp.exp(log_g[None, :] * (C - 1.0 - idx)[:, None])
    chunk_decay = jnp.exp(log_g * C)

    def chunks(a):
        return a.reshape(B, N, C, H, a.shape[-1]).transpose(1, 0, 2, 3, 4)

    def step(R, qkv):
        qc, kc, vc = qkv
        s = jnp.einsum('bihd,bjhd->bhij', qc, kc) * intra[None]
        o = jnp.einsum('bhij,bjhe->bihe', s, vc) + jnp.einsum('bihd,bhde->bihe', qc, R) * xi[None, :, :, None]
        R = R * chunk_decay[None, :, None, None] + jnp.einsum('bjhd,bjhe->bhde', kc * zeta[None, :, :, None], vc)
        return R, o

    R, o = lax.scan(step, state0, (chunks(q), chunks(k), chunks(v)))
    return o.transpose(1, 0, 2, 3, 4).reshape(B, L, H, DV), R


def token_mixer(h, rope, state0, w_in, hy_short_w, hy_w1, hy_b1, hy_w2, hy_b2, hy_w3, hy_b3,
                hy_freq, hy_decay, hy_bias, ret_decay_logit, ret_gn, w_br_hy, w_br_ret, w_out):
    dt = h.dtype
    B, L, _ = h.shape
    proj = h @ w_in
    o_ret = 3 * D_HY
    o_gate = o_ret + 4 * D_RET
    hy = dwconv3(proj[..., :o_ret], hy_short_w).astype(F32)
    x1, x2, v_h = jnp.split(hy, 3, axis=-1)
    kf = hyena_filter_fft(L, hy_w1, hy_b1, hy_w2, hy_b2, hy_w3, hy_b3, hy_freq, hy_decay)
    hb = hy_bias.astype(F32)
    z = x1 * fftconv(v_h, kf[:, 0], hb[0])
    y_hy = x2 * fftconv(z, kf[:, 1], hb[1])
    q, k, v, g = jnp.split(proj[..., o_ret:o_gate].astype(F32), 4, axis=-1)
    q = q.reshape(B, L, N_RET_HEADS, RET_HEAD_DIM)
    k = k.reshape(B, L, N_RET_HEADS, RET_HEAD_DIM)
    v = v.reshape(B, L, N_RET_HEADS, RET_HEAD_DIM)
    if rope is not None:
        q = apply_rope(q, rope[0], rope[1])
        k = apply_rope(k, rope[0], rope[1])
    k = k * RET_HEAD_DIM ** -0.5
    gamma = jax.nn.sigmoid(ret_decay_logit.astype(F32))
    s0 = state0.astype(F32)
    o_f, r_f = ret_chunk_scan(q, k, v, gamma[0], s0[:, 0])
    o_b, r_b = ret_chunk_scan(q[:, ::-1], k[:, ::-1], v[:, ::-1], gamma[1], s0[:, 1])
    o = o_f + o_b[:, ::-1]
    mu = jnp.mean(o, axis=-1, keepdims=True)
    var = jnp.mean(jnp.square(o - mu), axis=-1, keepdims=True)
    o = ((o - mu) * lax.rsqrt(var + GN_EPS)).reshape(B, L, D_RET) * ret_gn.astype(F32)
    y_ret = o * jax.nn.silu(g)
    g_hy, g_ret = jnp.split(jax.nn.sigmoid(proj[..., o_gate:].astype(F32)), 2, axis=-1)
    merged = (g_hy * (y_hy.astype(dt) @ w_br_hy).astype(F32)
              + g_ret * (y_ret.astype(dt) @ w_br_ret).astype(F32))
    out = merged.astype(dt) @ w_out
    return out.astype(dt), jnp.stack([r_f, r_b], axis=1)


def block(x, mod, rope, state0, norms, mixer_p, ffn_p):
    g_pre_m, g_post_m, g_pre_f, g_post_f = norms
    ffn_w_up, ffn_conv, ffn_w_down = ffn_p
    mod = mod.astype(x.dtype)
    shift_m, scale_m, gate_m, shift_f, scale_f, gate_f = jnp.split(mod, 6, axis=-1)
    h = rmsnorm(x, g_pre_m) * (1.0 + scale_m) + shift_m
    m, st = token_mixer(h, rope, state0, *mixer_p)
    x = x + (gate_m * rmsnorm(m, g_post_m)).astype(x.dtype)
    h = rmsnorm(x, g_pre_f) * (1.0 + scale_f) + shift_f
    u = dwconv3(h @ ffn_w_up, ffn_conv)
    a, b = jnp.split(u, 2, axis=-1)
    f = (jax.nn.gelu(a, approximate=True) * b) @ ffn_w_down
    x = x + (gate_f * rmsnorm(f, g_post_f)).astype(x.dtype)
    return x, st


def setup_inputs(seed: int = 0) -> dict:
    key = jax.random.key(seed)
    ks = jax.random.split(key, 40)

    def nrm(k, shape, scale):
        return jax.random.normal(k, shape, jnp.float32) * scale

    hy_rates = jnp.abs(jnp.linspace(math.log(HY_DECAY_TARGET) / HY_DECAY_FAST,
                                    math.log(HY_DECAY_TARGET) / HY_DECAY_SLOW, D_HY, dtype=jnp.float32))
    gam = 1.0 - 2.0 ** (-5.0 - jnp.arange(N_RET_HEADS, dtype=jnp.float32))
    ret_logit = jnp.log(gam) - jnp.log1p(-gam)
    FH = HY_FILTER_HIDDEN
    return {
        'x_prompt': nrm(ks[0], (BATCH, SEQ, D_MODEL), 1.0),
        'x_sample': nrm(ks[1], (DEC_BATCH, DEC_SEQ, D_MODEL), 1.0),
        'state_ret': nrm(ks[2], (DEC_BATCH, DEPTH, 2, N_RET_HEADS, RET_HEAD_DIM, RET_HEAD_DIM), 0.5),
        'c': nrm(ks[3], (DEC_BATCH, D_MODEL), 1.0),
        'c_ctx': nrm(ks[4], (D_MODEL,), 1.0),
        'w_ada': nrm(ks[5], (DEPTH, D_MODEL, 6 * D_MODEL), 0.5 * D_MODEL ** -0.5),
        'b_ada': nrm(ks[6], (DEPTH, 6 * D_MODEL), 0.02),
        'norm_pre_mix': 1.0 + nrm(ks[7], (DEPTH, D_MODEL), 0.05),
        'norm_post_mix': 1.0 + nrm(ks[8], (DEPTH, D_MODEL), 0.05),
        'norm_pre_ffn': 1.0 + nrm(ks[9], (DEPTH, D_MODEL), 0.05),
        'norm_post_ffn': 1.0 + nrm(ks[10], (DEPTH, D_MODEL), 0.05),
        'w_in': nrm(ks[11], (DEPTH, D_MODEL, N_IN), D_MODEL ** -0.5),
        'hy_short_w': nrm(ks[12], (DEPTH, 3, 3 * D_HY), 3 ** -0.5),
        'hy_w1': nrm(ks[13], (DEPTH, HY_EMB, FH), HY_EMB ** -0.5),
        'hy_b1': nrm(ks[14], (DEPTH, FH), 0.1),
        'hy_w2': nrm(ks[15], (DEPTH, FH, FH), FH ** -0.5),
        'hy_b2': nrm(ks[16], (DEPTH, FH), 0.1),
        'hy_w3': nrm(ks[17], (DEPTH, FH, 2 * HY_ORDER * D_HY), FH ** -0.5),
        'hy_b3': nrm(ks[18], (DEPTH, 2 * HY_ORDER * D_HY), 0.02),
        'hy_freq': 1.0 + nrm(ks[19], (DEPTH, 2, FH), 0.1),
        'hy_decay': hy_rates * (1.0 + nrm(ks[20], (DEPTH, 2, HY_ORDER, D_HY), 0.05)),
        'hy_bias': nrm(ks[21], (DEPTH, HY_ORDER, D_HY), 0.1),
        'ret_decay_logit': ret_logit + nrm(ks[22], (DEPTH, 2, N_RET_HEADS), 0.01),
        'ret_gn': 1.0 + nrm(ks[23], (DEPTH, D_RET), 0.05),
        'w_br_hy': nrm(ks[24], (DEPTH, D_HY, D_MODEL), D_HY ** -0.5),
        'w_br_ret': nrm(ks[25], (DEPTH, D_RET, D_MODEL), D_RET ** -0.5),
        'w_out': nrm(ks[26], (DEPTH, D_MODEL, D_MODEL), D_MODEL ** -0.5),
        'ffn_w_up': nrm(ks[27], (DEPTH, D_MODEL, 2 * D_FF), D_MODEL ** -0.5),
        'ffn_conv': nrm(ks[28], (DEPTH, 3, 2 * D_FF), 3 ** -0.5),
        'ffn_w_down': nrm(ks[29], (DEPTH, D_FF, D_MODEL), D_FF ** -0.5),
    }


def reference(x_prompt, x_sample, state_ret, c, c_ctx, w_ada, b_ada, norm_pre_mix, norm_post_mix,
              norm_pre_ffn, norm_post_ffn, w_in, hy_short_w, hy_w1, hy_b1, hy_w2, hy_b2, hy_w3, hy_b3,
              hy_freq, hy_decay, hy_bias, ret_decay_logit, ret_gn, w_br_hy, w_br_ret, w_out,
              ffn_w_up, ffn_conv, ffn_w_down):
    zero_state = jnp.zeros((x_prompt.shape[0], 2, N_RET_HEADS, RET_HEAD_DIM, RET_HEAD_DIM), F32)
    rope = rope_2d(x_sample.shape[1])
    x_p = x_prompt
    x_s = x_sample
    states = []
    for l in range(DEPTH):
        mixer_p = (w_in[l], hy_short_w[l], hy_w1[l], hy_b1[l], hy_w2[l], hy_b2[l], hy_w3[l], hy_b3[l],
                   hy_freq[l], hy_decay[l], hy_bias[l], ret_decay_logit[l], ret_gn[l],
                   w_br_hy[l], w_br_ret[l], w_out[l])
        norms = (norm_pre_mix[l], norm_post_mix[l], norm_pre_ffn[l], norm_post_ffn[l])
        ffn_p = (ffn_w_up[l], ffn_conv[l], ffn_w_down[l])
        mod_ctx = (jax.nn.silu(c_ctx) @ w_ada[l] + b_ada[l])[None, None, :]
        mod_lat = (jax.nn.silu(c) @ w_ada[l] + b_ada[l])[:, None, :]
        x_p, st = block(x_p, mod_ctx, None, zero_state, norms, mixer_p, ffn_p)
        x_s, _ = block(x_s, mod_lat, rope, state_ret[:, l], norms, mixer_p, ffn_p)
        states.append(st)
    new_state_ret = jnp.stack(states, axis=1)
    return (x_p, x_s, new_state_ret)
```

```cpp
#include <hip/hip_runtime.h>
#include <cstdio>
#include <cstdint>

#ifndef MK_N_LAUNCHES
#define MK_N_LAUNCHES 1
#endif

#define LAS __attribute__((address_space(3)))
#define GAS __attribute__((address_space(1)))
typedef unsigned short bf16_t;
typedef short bf16x8 __attribute__((ext_vector_type(8)));
typedef float f32x4 __attribute__((ext_vector_type(4)));
typedef float f32x2 __attribute__((ext_vector_type(2)));
typedef float f32x16 __attribute__((ext_vector_type(16)));
typedef unsigned u32x4 __attribute__((ext_vector_type(4)));
typedef unsigned u32x2 __attribute__((ext_vector_type(2)));

constexpr int DM = 2048, TP = 8192, TSM = 2048, TT = 10240, LP = 256, LS = 1024;
constexpr int NIN = 11264, DHY = 1024, NH = 8, HD = 128, DFF = 5632;
constexpr int NPJ = 8192;
constexpr int O_Q = 0, O_K = 1024, O_V = 2048, O_G = 3072, O_GHY = 4096, O_GRET = 6144;
constexpr int NWAVES = 8, NTHREADS = 512;

constexpr size_t MiB = 1u << 20;
constexpr size_t WS_CTL = 0, CTL_ZERO_BYTES = 1 * MiB;
constexpr size_t WS_MODP = 1 * MiB;
constexpr size_t WS_MODC = 1 * MiB + 512 * 1024;
constexpr int CW_ADA = 2048;
enum { MC_AM = 0, MC_BM, MC_GM, MC_AF, MC_BF, MC_GF };
constexpr size_t WS_R1 = 6 * MiB;
constexpr size_t WS_R2 = 46 * MiB;
constexpr size_t WS_X1T = 46 * MiB, WS_X2T = 66 * MiB, WS_VT = 276 * MiB;
constexpr size_t WS_WOUT = 86 * MiB, WS_WBRH = 94 * MiB, WS_WBRR = 98 * MiB;
constexpr size_t WS_PROJ = 116 * MiB;
constexpr size_t WS_WUP = 336 * MiB, WS_WDOWN = 380 * MiB, WS_END = 402 * MiB;
constexpr size_t WS_ACT2 = 116 * MiB, WS_FSLAB = 226 * MiB, WS_UE = 292 * MiB;
constexpr size_t OUT_WIN = 0, OUT_F256 = 44 * MiB, OUT_F1024 = 48 * MiB, OUT_STATE = 80 * MiB;
constexpr int CW_BAR = 4096;

typedef __bf16 bf16v2 __attribute__((ext_vector_type(2)));
__device__ __forceinline__ unsigned pk2(float lo, float hi) { const f32x2 v = {lo, hi}; return __builtin_bit_cast(unsigned, __builtin_convertvector(v, bf16v2)); }
__device__ __forceinline__ unsigned f2bf(float f) { return pk2(f, 0.f) & 0xffffu; }
__device__ __forceinline__ float bflo(unsigned w) { return __builtin_bit_cast(float, w << 16); }
__device__ __forceinline__ float bfhi(unsigned w) { return __builtin_bit_cast(float, w & 0xffff0000u); }
__device__ __forceinline__ float bf2f(bf16_t b) { return __builtin_bit_cast(float, ((unsigned)b) << 16); }
__device__ __forceinline__ f32x4 bf4(u32x2 w) { return (f32x4){bflo(w.x), bfhi(w.x), bflo(w.y), bfhi(w.y)}; }
__device__ __forceinline__ float sigmoidf_(float x) { return 1.0f / (1.0f + __expf(-x)); }

namespace pg8 {
constexpr int BM = 256, BK = 64, HALF = 128, HTB = HALF * BK * 2, STAGE_BYTES = 8 * HTB, NXCD = 8, WGM = 8;
__host__ __device__ __forceinline__ int lds_byte(int r, int c) { const int st = (r >> 4) * 2 + (c >> 5), rr = r & 15, cc = c & 31, ob = rr * 64 + cc * 2; return st * 1024 + (ob ^ (((ob >> 9) & 1) << 5)); }
__host__ __device__ __forceinline__ void stage_rc(int b, int& R, int& C) { const int st = b / 1024, sb = b % 1024, swz = sb ^ (((sb >> 9) & 1) << 5); R = (st >> 1) * 16 + swz / 64; C = (st & 1) * 32 + (swz % 64) / 2; }
__host__ __device__ __forceinline__ int perm32(int rho) { const int n = rho >> 4, i = rho & 15; return 8 * (i >> 2) + 4 * n + (i & 3); }

struct Unit { int pm, pn, sub, kt0, nkt, part; };
struct Gemm { const bf16_t* A0; const bf16_t* A1; const bf16_t* B0; const bf16_t* B1; int M, N, K;
    __device__ __forceinline__ const char* a(int s) const { return (const char*)(s ? A1 : A0); } __device__ __forceinline__ const char* b(int s) const { return (const char*)(s ? B1 : B0); } };

struct Order {
    int nM, nN, nwg, G, c, nsub, ktu; int vc2 = -1;
    __device__ __forceinline__ void init(int M, int N, int K, int G_, int c_, int nsub_) { nM = M / BM; nN = N / BM; nwg = nM * nN; G = G_; c = c_; nsub = nsub_; ktu = K / BK; }
    __device__ __forceinline__ bool next(int i, Unit& u) const {
        const int ii = i / nsub; u.sub = i - ii * nsub; u.kt0 = 0; u.nkt = ktu; u.part = 0;
        const long L = (ii == 1 && vc2 >= 0) ? (long)G + vc2 : (long)ii * G + c; if (L >= nwg) return false;
        int wgid = (int)L; { const int q = nwg / NXCD, r = nwg % NXCD, xcd = wgid % NXCD, off = wgid / NXCD; wgid = (xcd < r ? xcd * (q + 1) : r * (q + 1) + (xcd - r) * q) + off; }
        const int nig = WGM * nN, gid = wgid / nig, fm = gid * WGM, gsz = (nM - fm) < WGM ? (nM - fm) : WGM;
        u.pm = fm + ((wgid % nig) % gsz); u.pn = (wgid % nig) / gsz; return true;
    }
};

struct TwoRoundOrder {
    int ktu, vc; bool ok;
    __device__ __forceinline__ void init(int M, int N, int K, int G, int vc_) { ktu = K / BK; vc = vc_; ok = (G == 256 && M == 10240 && N == 2048 && (ktu % 8) == 0); }
    __device__ __forceinline__ bool next(int i, Unit& u) const {
        const int x = vc >> 5, j = vc & 31; u.sub = 0;
        if (i == 0) { u.pm = 8 * (x >> 1) + (j & 7); u.pn = 4 * (x & 1) + (j >> 3); u.kt0 = 0; u.nkt = ktu; u.part = 0; return true; }
        if (i == 1) { const int q = x & 3; u.pm = 32 + (j & 7); u.pn = 4 * (x >> 2) + (j >> 3); u.kt0 = q * (ktu >> 2); u.nkt = ktu >> 2; u.part = q; return true; }
        return false;
    }
};
__device__ __forceinline__ unsigned cvt_pk_bf16(float lo, float hi) { unsigned r; asm volatile("v_cvt_pk_bf16_f32 %0, %1, %2" : "=v"(r) : "v"(lo), "v"(hi)); return r; }

struct EpiF32 {
    static constexpr bool PERM = false, SWAP = false;
    float* C; int ldc; size_t slab;
    __device__ __forceinline__ bool keep(const Unit&) const { return false; }
    __device__ __forceinline__ void operator()(f32x4 (&acc)[2][2][4][2], const Unit& u, int wr, int wc, int fr, int fq) const {
        const int row0 = u.pm * BM + wr * 64 + fr, col0 = u.pn * BM + wc * 32 + 4 * fq;
        float* Cp = u.part == 0 ? C : C + slab + (size_t)(u.part - 1) * 2048 * ldc - (size_t)8192 * ldc;
#pragma unroll
        for (int ai = 0; ai < 2; ++ai)
#pragma unroll
            for (int m = 0; m < 4; ++m) { float* rowp = Cp + (size_t)(row0 + ai * HALF + m * 16) * ldc + col0;
#pragma unroll
                for (int bj = 0; bj < 2; ++bj)
#pragma unroll
                    for (int n = 0; n < 2; ++n) *(f32x4*)(rowp + bj * HALF + n * 16) = acc[ai][bj][m][n]; }
    }
};
struct EpiBf16 {
    static constexpr bool PERM = true, SWAP = false;
    bf16_t* O; int ldc; size_t slab;
    __device__ __forceinline__ bool keep(const Unit&) const { return false; }
    __device__ __forceinline__ void operator()(f32x4 (&acc)[2][2][4][2], const Unit& u, int wr, int wc, int fr, int fq) const {
        const int row0 = u.pm * BM + wr * 64 + fr, col0 = u.pn * BM + wc * 32 + 8 * fq;
        bf16_t* Op = u.part == 0 ? O : O + slab + (size_t)(u.part - 1) * 2048 * ldc - (size_t)8192 * ldc;
#pragma unroll
        for (int ai = 0; ai < 2; ++ai)
#pragma unroll
            for (int m = 0; m < 4; ++m) { bf16_t* rowp = Op + (size_t)(row0 + ai * HALF + m * 16) * ldc + col0;
#pragma unroll
                for (int bj = 0; bj < 2; ++bj) { const f32x4 v0 = acc[ai][bj][m][0], v1 = acc[ai][bj][m][1];
                    u32x4 w; w.x = cvt_pk_bf16(v0[0], v0[1]); w.y = cvt_pk_bf16(v0[2], v0[3]); w.z = cvt_pk_bf16(v1[0], v1[1]); w.w = cvt_pk_bf16(v1[2], v1[3]);
                    *(u32x4*)(rowp + bj * HALF) = w; } }
    }
};
__device__ __forceinline__ float dpp_ror1(float x) { return __builtin_bit_cast(float, __builtin_amdgcn_update_dpp(0, __builtin_bit_cast(int, x), 0x121, 0xF, 0xF, false)); }
__device__ __forceinline__ float dpp_ror15(float x) { return __builtin_bit_cast(float, __builtin_amdgcn_update_dpp(0, __builtin_bit_cast(int, x), 0x12F, 0xF, 0xF, false)); }
__device__ __forceinline__ float gelu_gate(float a, float b) { const float u = 1.5957691216057308f * (a + 0.044715f * a * a * a); return a * __builtin_amdgcn_rcpf(1.0f + __expf(-u)) * b; }
struct EpiGate {
    static constexpr bool PERM = true, SWAP = false;
    bf16_t* ACT; bf16_t* UE; const float* cw;
    __device__ __forceinline__ bool keep(const Unit&) const { return false; }
    __device__ __forceinline__ void operator()(f32x4 (&acc)[2][2][4][2], const Unit& u, int wr, int wc, int fr, int fq) const {
        const int colh = u.pn * HALF + wc * 32 + 8 * fq;
#pragma unroll
        for (int ai = 0; ai < 2; ++ai) { const int strip = 2 * ai + wr;
            if (fr < 2 || fr >= 14) { const int m = fr < 2 ? 0 : 3, w = fr < 2 ? fr : fr - 12;
                bf16_t* ue = UE + ((size_t)((u.pm * 4 + strip) * 4 + w) * 2) * DFF + colh;
#pragma unroll
                for (int bj = 0; bj < 2; ++bj) { const f32x4 v0 = m == 0 ? acc[ai][bj][0][0] : acc[ai][bj][3][0], v1 = m == 0 ? acc[ai][bj][0][1] : acc[ai][bj][3][1];
                    u32x4 q; q.x = cvt_pk_bf16(v0[0], v0[1]); q.y = cvt_pk_bf16(v0[2], v0[3]); q.z = cvt_pk_bf16(v1[0], v1[1]); q.w = cvt_pk_bf16(v1[2], v1[3]); *(u32x4*)(ue + (size_t)bj * DFF) = q; } } }
        unsigned pk[2][4][2];
#pragma unroll
        for (int n = 0; n < 2; ++n) {
            f32x4 wa[3], wb[3];
#pragma unroll
            for (int k = 0; k < 3; ++k) { wa[k] = *(const f32x4*)(cw + k * (2 * DFF) + colh + 4 * n); wb[k] = *(const f32x4*)(cw + k * (2 * DFF) + DFF + colh + 4 * n); }
#pragma unroll
            for (int ai = 0; ai < 2; ++ai) {
                float o[4][4];
#pragma unroll
                for (int j = 0; j < 4; ++j) {
                    float ua[4], ub[4];
#pragma unroll
                    for (int bj = 0; bj < 2; ++bj) {
                        float R[4], L[4];
#pragma unroll
                        for (int m = 0; m < 4; ++m) { R[m] = dpp_ror1(acc[ai][bj][m][n][j]); L[m] = dpp_ror15(acc[ai][bj][m][n][j]); }
#pragma unroll
                        for (int m = 0; m < 4; ++m) { const float up = fr == 0 ? (m > 0 ? R[m > 0 ? m - 1 : 0] : 0.f) : R[m], dn = fr == 15 ? (m < 3 ? L[m < 3 ? m + 1 : 3] : 0.f) : L[m];
                            const float cv = (bj == 0 ? wa[0][j] : wb[0][j]) * up + (bj == 0 ? wa[1][j] : wb[1][j]) * acc[ai][bj][m][n][j] + (bj == 0 ? wa[2][j] : wb[2][j]) * dn;
                            if (bj == 0) ua[m] = cv; else ub[m] = cv; } }
#pragma unroll
                    for (int m = 0; m < 4; ++m) o[m][j] = gelu_gate(ua[m], ub[m]);
                }
#pragma unroll
                for (int m = 0; m < 4; ++m) { pk[ai][m][0] = n == 0 ? cvt_pk_bf16(o[m][0], o[m][1]) : pk[ai][m][0]; pk[ai][m][1] = n == 0 ? cvt_pk_bf16(o[m][2], o[m][3]) : pk[ai][m][1];
                    if (n == 1) { const bool edge = (m == 0 && fr == 0) || (m == 3 && fr == 15);
                        u32x4 q; q.x = pk[ai][m][0]; q.y = pk[ai][m][1]; q.z = cvt_pk_bf16(o[m][0], o[m][1]); q.w = cvt_pk_bf16(o[m][2], o[m][3]);
                        if (!edge) *(u32x4*)(ACT + (size_t)(u.pm * BM + ai * HALF + wr * 64 + m * 16 + fr) * DFF + colh) = q; } }
            }
        }
    }
};
struct EpiHyT {
    static constexpr bool PERM = false, SWAP = true;
    bf16_t* x1t; bf16_t* x2t; bf16_t* vt;
    __device__ __forceinline__ bool keep(const Unit&) const { return false; }
    __device__ __forceinline__ void operator()(f32x4 (&acc)[2][2][4][2], const Unit& u, int wr, int wc, int fr, int fq) const {
        const int ten = u.pn >> 2; bf16_t* pt = ten == 2 ? vt : x1t + (size_t)ten * ((size_t)DHY * TT);
        const int ch0 = (u.pn & 3) * BM + wc * 32 + fr, tok0 = u.pm * BM + wr * 64 + 4 * fq;
#pragma unroll
        for (int bj = 0; bj < 2; ++bj)
#pragma unroll
            for (int n = 0; n < 2; ++n) { bf16_t* cp = pt + (size_t)(ch0 + bj * HALF + n * 16) * TT + tok0;
#pragma unroll
                for (int ai = 0; ai < 2; ++ai)
#pragma unroll
                    for (int m = 0; m < 4; ++m) { const f32x4 v = acc[ai][bj][m][n]; u32x2 w; w.x = cvt_pk_bf16(v[0], v[1]); w.y = cvt_pk_bf16(v[2], v[3]); *(u32x2*)(cp + ai * HALF + m * 16) = w; } }
    }
};
struct EpiMerge {
    static constexpr bool PERM = true, SWAP = false;
    bf16_t* O; const bf16_t* proj;
    __device__ __forceinline__ bool keep(const Unit& u) const { return u.sub == 0; }
    static __device__ __forceinline__ f32x4 rcp4(const f32x4 v) { f32x4 r; r.x = __builtin_amdgcn_rcpf(v.x); r.y = __builtin_amdgcn_rcpf(v.y); r.z = __builtin_amdgcn_rcpf(v.z); r.w = __builtin_amdgcn_rcpf(v.w); return r; }
    static __device__ __forceinline__ f32x4 enlo(const u32x4 g) { f32x4 r; r.x = __expf(-fminf(fmaxf(bflo(g.x), -30.f), 30.f)); r.y = __expf(-fminf(fmaxf(bfhi(g.x), -30.f), 30.f)); r.z = __expf(-fminf(fmaxf(bflo(g.y), -30.f), 30.f)); r.w = __expf(-fminf(fmaxf(bfhi(g.y), -30.f), 30.f)); return r; }
    static __device__ __forceinline__ f32x4 enhi(const u32x4 g) { f32x4 r; r.x = __expf(-fminf(fmaxf(bflo(g.z), -30.f), 30.f)); r.y = __expf(-fminf(fmaxf(bfhi(g.z), -30.f), 30.f)); r.z = __expf(-fminf(fmaxf(bflo(g.w), -30.f), 30.f)); r.w = __expf(-fminf(fmaxf(bfhi(g.w), -30.f), 30.f)); return r; }
    __device__ __forceinline__ void operator()(f32x4 (&acc)[2][2][4][2], const Unit& u, int wr, int wc, int fr, int fq) const {
        const int row0 = u.pm * BM + wr * 64 + fr, col0 = u.pn * BM + wc * 32 + 8 * fq;
        if (u.sub == 0) {
#pragma unroll
            for (int ai = 0; ai < 2; ++ai)
#pragma unroll
                for (int m = 0; m < 4; ++m) { const size_t row = (size_t)(row0 + ai * HALF + m * 16); const bf16_t* prow = proj + row * NPJ + col0;
#pragma unroll
                    for (int bj = 0; bj < 2; ++bj) {
                        const u32x4 gb = *(const u32x4*)(prow + O_GRET + bj * HALF), ga = *(const u32x4*)(prow + O_GHY + bj * HALF);
                        const f32x4 b0 = enlo(gb), b1 = enhi(gb), a0 = enlo(ga), a1 = enhi(ga);
                        acc[ai][bj][m][0] = acc[ai][bj][m][0] * ((1.0f + b0) * rcp4(1.0f + a0));
                        acc[ai][bj][m][1] = acc[ai][bj][m][1] * ((1.0f + b1) * rcp4(1.0f + a1)); } }
        } else {
#pragma unroll
            for (int ai = 0; ai < 2; ++ai)
#pragma unroll
                for (int m = 0; m < 4; ++m) { const size_t row = (size_t)(row0 + ai * HALF + m * 16); const bf16_t* prow = proj + row * NPJ + col0;
#pragma unroll
                    for (int bj = 0; bj < 2; ++bj) {
                        const u32x4 gb = *(const u32x4*)(prow + O_GRET + bj * HALF);
                        const f32x4 b0 = enlo(gb), b1 = enhi(gb);
                        const f32x4 v0 = acc[ai][bj][m][0] * rcp4(1.0f + b0), v1 = acc[ai][bj][m][1] * rcp4(1.0f + b1);
                        u32x4 w; w.x = cvt_pk_bf16(v0[0], v0[1]); w.y = cvt_pk_bf16(v0[2], v0[3]); w.z = cvt_pk_bf16(v1[0], v1[1]); w.w = cvt_pk_bf16(v1[2], v1[3]);
                        *(u32x4*)(O + row * DM + col0 + bj * HALF) = w; } }
        }
    }
};

template <class Epi, class Sched>
__device__ __forceinline__ void gemm_phase(LAS unsigned char* lds, const Gemm g, const Sched& S, const Epi& E) {
    int tid = threadIdx.x; asm volatile("" : "+v"(tid));
    const int wid = __builtin_amdgcn_readfirstlane(tid >> 6), lane = tid & 63, wr = wid >> 2, wc = wid & 3, fr = lane & 15, fq = lane >> 4;
    const int K = g.K;
    unsigned voffA[2], voffB[2];
#pragma unroll
    for (int i = 0; i < 2; ++i) { int R, C; stage_rc(tid * 16 + i * 8192, R, C); const int Rb = Epi::PERM ? ((R & ~31) + perm32(R & 31)) : R;
        voffA[i] = (unsigned)(R * K + C) * 2u; voffB[i] = (unsigned)(Rb * K + C) * 2u; }
    const size_t kstep = (size_t)(BK * 2);
    const size_t hstep = (size_t)HALF * K * 2;
    const size_t tstep = 2 * hstep;
    const unsigned ldsw = (unsigned)wid * 1024u;
    const int aoff = lds_byte(wr * 64 + fr, fq * 8), boff = lds_byte(wc * 32 + fr, fq * 8);
#define PG8_SA(b, h) (((b) * 2 + (h)) * HTB)
#define PG8_SB(b, h) ((4 + (b) * 2 + (h)) * HTB)
#define PG8_STAGE(bufoff, gbase, voff) do { _Pragma("unroll") for (int _i = 0; _i < 2; ++_i) \
        __builtin_amdgcn_global_load_lds((const unsigned*)((const char*)(gbase) + (voff)[_i]), (LAS unsigned*)(lds + (bufoff) + ldsw + _i * 8192), 16, 0, 0); } while (0)
#define PG8_LDA(dst, b, h) do { _Pragma("unroll") for (int m = 0; m < 4; ++m) _Pragma("unroll") for (int k = 0; k < 2; ++k) dst[m][k] = *(const LAS bf16x8*)(lds + PG8_SA(b, h) + aoff + m * 2048 + k * 1024); } while (0)
#define PG8_LDB(dst, b, h) do { _Pragma("unroll") for (int n = 0; n < 2; ++n) _Pragma("unroll") for (int k = 0; k < 2; ++k) dst[n][k] = *(const LAS bf16x8*)(lds + PG8_SB(b, h) + boff + n * 2048 + k * 1024); } while (0)
#define PG8_MMA(ai, bj, At, Bt) do { __builtin_amdgcn_s_setprio(1); _Pragma("unroll") for (int m = 0; m < 4; ++m) _Pragma("unroll") for (int n = 0; n < 2; ++n) _Pragma("unroll") for (int k = 0; k < 2; ++k) \
        acc[ai][bj][m][n] = Epi::SWAP ? __builtin_amdgcn_mfma_f32_16x16x32_bf16(At[m][k], Bt[n][k], acc[ai][bj][m][n], 0, 0, 0) : __builtin_amdgcn_mfma_f32_16x16x32_bf16(Bt[n][k], At[m][k], acc[ai][bj][m][n], 0, 0, 0); __builtin_amdgcn_s_setprio(0); } while (0)
#define PG8_WAIT_V(n) asm volatile("s_waitcnt vmcnt(" #n ")" ::: "memory")
#define PG8_WAIT_L(n) asm volatile("s_waitcnt lgkmcnt(" #n ")" ::: "memory")
#define PG8_BAR __builtin_amdgcn_s_barrier()
#define PG8_SCHED __builtin_amdgcn_sched_barrier(0)
    Unit cur, nxt; int ui = 0;
    if (!S.next(0, cur)) return;
    f32x4 acc[2][2][4][2];
#pragma unroll
    for (int a = 0; a < 2; ++a)
#pragma unroll
        for (int b = 0; b < 2; ++b)
#pragma unroll
            for (int m = 0; m < 4; ++m)
#pragma unroll
                for (int n = 0; n < 2; ++n) acc[a][b][m][n] = (f32x4){0.f, 0.f, 0.f, 0.f};
    bf16x8 At[4][2], B0[2][2], B1[2][2];
    const char* cA = g.a(cur.sub) + (size_t)cur.pm * tstep + (size_t)cur.kt0 * kstep; const char* cB = g.b(cur.sub) + (size_t)cur.pn * tstep + (size_t)cur.kt0 * kstep;
    PG8_STAGE(PG8_SB(0, 0), cB, voffB); PG8_STAGE(PG8_SB(0, 1), cB + hstep, voffB); PG8_STAGE(PG8_SA(0, 0), cA, voffA); PG8_STAGE(PG8_SA(0, 1), cA + hstep, voffA);
    if (wr == 1) PG8_BAR;
    PG8_WAIT_V(2); PG8_BAR;
    PG8_STAGE(PG8_SB(1, 0), cB + kstep, voffB); PG8_STAGE(PG8_SA(1, 0), cA + kstep, voffA); PG8_STAGE(PG8_SB(1, 1), cB + hstep + kstep, voffB);
    PG8_WAIT_V(6); PG8_BAR;
    for (;;) {
        const bool has_next = S.next(ui + 1, nxt);
        const char* nA = has_next ? g.a(nxt.sub) + (size_t)nxt.pm * tstep + (size_t)nxt.kt0 * kstep : cA; const char* nB = has_next ? g.b(nxt.sub) + (size_t)nxt.pn * tstep + (size_t)nxt.kt0 * kstep : cB;
        const int nt = cur.nkt;
        for (int t = 0; t < nt; t += 2) {
            const bool last = (t == nt - 2);
            const char* a1 = cA + (size_t)(t + 1) * kstep;
            const char* a2 = last ? nA : cA + (size_t)(t + 2) * kstep; const char* b2 = last ? nB : cB + (size_t)(t + 2) * kstep;
            const char* a3 = a2 + kstep; const char* b3 = b2 + kstep;
            PG8_LDB(B0, 0, 0); PG8_LDB(B1, 0, 1); PG8_SCHED; PG8_LDA(At, 0, 0); PG8_STAGE(PG8_SA(1, 1), a1 + hstep, voffA);
            PG8_WAIT_V(8); PG8_WAIT_L(0); PG8_BAR; PG8_MMA(0, 0, At, B0); PG8_MMA(0, 1, At, B1); PG8_BAR; PG8_SCHED;
            PG8_LDA(At, 0, 1); PG8_STAGE(PG8_SB(0, 0), b2, voffB); PG8_STAGE(PG8_SB(0, 1), b2 + hstep, voffB); PG8_STAGE(PG8_SA(0, 0), a2, voffA);
            PG8_WAIT_V(8); PG8_WAIT_L(0); PG8_BAR; PG8_MMA(1, 0, At, B0); PG8_MMA(1, 1, At, B1); PG8_BAR; PG8_SCHED;
            PG8_LDB(B0, 1, 0); PG8_LDB(B1, 1, 1); PG8_SCHED; PG8_LDA(At, 1, 0); PG8_STAGE(PG8_SA(0, 1), a2 + hstep, voffA);
            PG8_WAIT_V(8); PG8_WAIT_L(0); PG8_BAR; PG8_MMA(0, 0, At, B0); PG8_MMA(0, 1, At, B1); PG8_BAR; PG8_SCHED;
            PG8_LDA(At, 1, 1); PG8_STAGE(PG8_SB(1, 0), b3, voffB); PG8_STAGE(PG8_SB(1, 1), b3 + hstep, voffB); PG8_STAGE(PG8_SA(1, 0), a3, voffA);
            PG8_WAIT_V(8); PG8_WAIT_L(0); PG8_BAR; PG8_MMA(1, 0, At, B0); PG8_MMA(1, 1, At, B1); PG8_BAR; PG8_SCHED;
        }
        if (wr == 0) PG8_BAR;
        E(acc, cur, wr, wc, fr, fq);
        if (!has_next) break;
        if (!E.keep(cur)) {
#pragma unroll
            for (int a = 0; a < 2; ++a)
#pragma unroll
                for (int b = 0; b < 2; ++b)
#pragma unroll
                    for (int m = 0; m < 4; ++m)
#pragma unroll
                        for (int n = 0; n < 2; ++n) acc[a][b][m][n] = (f32x4){0.f, 0.f, 0.f, 0.f};
        }
        cur = nxt; cA = nA; cB = nB; ++ui;
        if (wr == 1) PG8_BAR;
    }
    PG8_WAIT_V(0);
    PG8_BAR;
#undef PG8_SA
#undef PG8_SB
#undef PG8_STAGE
#undef PG8_LDA
#undef PG8_LDB
#undef PG8_MMA
#undef PG8_WAIT_V
#undef PG8_WAIT_L
#undef PG8_BAR
#undef PG8_SCHED
}
}

#define XB_TMO      128
#define XB_XCNT(j)  (256  + 64 * (j))
#define XB_XSUB(j)  (1280 + 64 * (j))
#define XB_XGEN(j)  (2304 + 64 * (j))
#define XB_TOP      3328
#define XB_TOPGEN   3392
#define XCD_BAR_WORDS 3456
#define XB_SPIN_CAP (1u << 20)
__device__ __forceinline__ unsigned xb_ld(unsigned* p)              { return __hip_atomic_load(p, __ATOMIC_RELAXED, __HIP_MEMORY_SCOPE_AGENT); }
__device__ __forceinline__ unsigned xb_add(unsigned* p, unsigned v) { return __hip_atomic_fetch_add(p, v, __ATOMIC_RELAXED, __HIP_MEMORY_SCOPE_AGENT); }
__device__ __forceinline__ unsigned xb_xcc_id() { return (unsigned)__builtin_amdgcn_s_getreg((3 << 11) | 20) & 0xFu; }
#define XB_SPIN(cond, bar) do { unsigned _sp = 0; while (cond) { __builtin_amdgcn_s_sleep(1); \
    if ((++_sp & 255u) == 0u) { if (xb_ld(&(bar)[XB_TMO])) break; if (_sp > XB_SPIN_CAP) { atomicAdd(&(bar)[XB_TMO], 1u); break; } } } } while (0)
struct XcdBarrier { unsigned* bar; unsigned x; volatile LAS unsigned* st; };
__device__ __forceinline__ XcdBarrier xcd_barrier_post(unsigned* bar, volatile LAS unsigned* st) {
    XcdBarrier b; b.bar = bar; b.x = xb_xcc_id(); b.st = st;
    if (threadIdx.x == 0) (void)xb_add(&bar[XB_XCNT(b.x)], 1u);
    return b;
}
__device__ __forceinline__ void xcd_barrier_complete(unsigned* bar, unsigned x, unsigned& nloc, unsigned& nx) {
    const unsigned G = gridDim.x * gridDim.y * gridDim.z;
    unsigned sum, cnt, mine, sp = 0u;
    for (;;) {
        sum = 0u; cnt = 0u; mine = 0u;
#pragma unroll
        for (unsigned j = 0; j < 16; ++j) { const unsigned c = xb_ld(&bar[XB_XCNT(j)]); sum += c; cnt += (c > 0u) ? 1u : 0u; mine = (j == x) ? c : mine; }
        if (sum == G) break;
        __builtin_amdgcn_s_sleep(1);
        if ((++sp & 255u) == 0u) { if (xb_ld(&bar[XB_TMO])) break; if (sp > XB_SPIN_CAP) { atomicAdd(&bar[XB_TMO], 1u); break; } }
    }
    nloc = mine > 0u ? mine : 1u; nx = cnt > 0u ? cnt : 1u;
}
__device__ __forceinline__ void xcd_barrier(const XcdBarrier& b) {
    asm volatile("s_waitcnt vmcnt(0)" ::: "memory");
    __syncthreads();
    if (threadIdx.x == 0) {
        unsigned* bar = b.bar;
        __builtin_amdgcn_s_waitcnt(0);
        unsigned nloc = b.st[0], nx = b.st[1];
        if (nloc == 0u) { xcd_barrier_complete(bar, b.x, nloc, nx); b.st[0] = nloc; b.st[1] = nx; }
        const unsigned old = xb_add(&bar[XB_XSUB(b.x)], 1u);
        const unsigned gen = old / nloc;
        if (old + 1u == (gen + 1u) * nloc) {
            __builtin_amdgcn_fence(__ATOMIC_RELEASE, "agent");
            asm volatile("s_waitcnt vmcnt(0)" ::: "memory");
            const unsigned og = xb_add(&bar[XB_TOP], 1u);
            const unsigned tg = og / nx;
            if (og + 1u == (tg + 1u) * nx) xb_add(&bar[XB_TOPGEN], 1u);
            else XB_SPIN(xb_ld(&bar[XB_TOPGEN]) == tg, bar);
            __builtin_amdgcn_fence(__ATOMIC_ACQUIRE, "agent");
            xb_add(&bar[XB_XGEN(b.x)], 1u);
            asm volatile("s_waitcnt vmcnt(0)" ::: "memory");
        } else {
            XB_SPIN(xb_ld(&bar[XB_XGEN(b.x)]) == gen, bar);
            __builtin_amdgcn_fence(__ATOMIC_ACQUIRE, "agent");
            asm volatile("s_waitcnt vmcnt(0)" ::: "memory");
        }
    }
    __syncthreads();
}

constexpr int LDS_BYTES = 155648;
constexpr int LDS_MISC = 155648 - 256;
struct Args { const GAS float* in[30]; GAS float* out; GAS unsigned char* ws; int ph_lo, ph_hi, li, pad; };
struct Ctx {
    LAS unsigned char* lds; int tid, lane, wave, vcu, G;
    const GAS float* const* in_; GAS float* out_; GAS unsigned char* ws_;
    __device__ __forceinline__ const float* inp(int i) const { return (const float*)in_[i]; }
    __device__ __forceinline__ unsigned char* wsp() const { return (unsigned char*)ws_; }
    __device__ __forceinline__ float* outp() const { return (float*)out_; }
};
enum { I_XP = 0, I_XS, I_STATE, I_C, I_CCTX, I_WADA, I_BADA, I_NPREM, I_NPOSTM, I_NPREF, I_NPOSTF, I_WIN, I_HYSW, I_HYW1, I_HYB1, I_HYW2, I_HYB2, I_HYW3, I_HYB3,
       I_HYFREQ, I_HYDECAY, I_HYBIAS, I_RETLOGIT, I_RETGN, I_WBRH, I_WBRR, I_WOUT, I_WUP, I_FFNCONV, I_WDOWN };

__device__ __forceinline__ Ctx phase_ctx(const Ctx& F) { Ctx G = F; G.tid = threadIdx.x; G.lane = G.tid & 63; asm volatile("" : "+s"(G.out_), "+s"(G.ws_)); return G; }
__device__ __forceinline__ Ctx fresh(const Ctx& F) { Ctx G = F; G.tid = threadIdx.x; G.lane = G.tid & 63; asm volatile("" : "+v"(G.tid), "+v"(G.lane)); return G; }
__device__ __forceinline__ float wave_sum(float v) {
#pragma unroll
    for (int o = 1; o < 64; o <<= 1) v += __shfl_xor(v, o);
    return v;
}
__device__ __forceinline__ int row_mv(int r) { return r < TP ? 0 : 1 + ((r - TP) >> 10); }
__device__ __forceinline__ const float* x_row(const Ctx& F, int r) { return r < TP ? F.inp(I_XP) + (size_t)r * DM : F.inp(I_XS) + (size_t)(r - TP) * DM; }

template <bool GATEP = false>
__device__ __forceinline__ void transpose_item(const float* W, int K, int N, bf16_t* WT, int item, int lane) {
    const int nblk = N / 64, kb = item / nblk, nb = item % nblk, k0 = 64 * kb, n0 = 64 * nb;
    const int r0 = !GATEP ? n0 : (n0 < DFF ? 256 * (n0 >> 7) + (n0 & 127) : 256 * ((n0 - DFF) >> 7) + 128 + ((n0 - DFF) & 127));
    const float* src = W + (size_t)k0 * N + n0 + lane;
    float v[64];
#pragma unroll
    for (int i = 0; i < 64; ++i) v[i] = src[(size_t)i * N];
    bf16_t* dst = WT + (size_t)(r0 + lane) * K + k0;
#pragma unroll
    for (int j = 0; j < 8; ++j) { u32x4 o; o.x = pk2(v[8 * j], v[8 * j + 1]); o.y = pk2(v[8 * j + 2], v[8 * j + 3]); o.z = pk2(v[8 * j + 4], v[8 * j + 5]); o.w = pk2(v[8 * j + 6], v[8 * j + 7]);
        *(u32x4*)(dst + 8 * j) = o; }
}

__device__ __forceinline__ void ada_item(const Ctx& F0, int it) {
    const Ctx F = fresh(F0);
    const int cs = it >> 1, kh = it & 1, c0 = 96 * cs, k0 = 1024 * kh, tid = F.tid;
    LAS float* sv = (LAS float*)F.lds;
    LAS float* red = sv + 3 * 1024;
    for (int i = tid; i < 1024; i += NTHREADS) {
        const float a = F.inp(I_CCTX)[k0 + i], b = F.inp(I_C)[k0 + i], c = F.inp(I_C)[DM + k0 + i];
        sv[i] = a * sigmoidf_(a); sv[1024 + i] = b * sigmoidf_(b); sv[2048 + i] = c * sigmoidf_(c);
    }
    __syncthreads();
    const int cl = tid % 24, rg = tid / 24;
    if (rg < 21) {
        f32x4 a0 = {0, 0, 0, 0}, a1 = {0, 0, 0, 0}, a2 = {0, 0, 0, 0};
        const float* wp = F.inp(I_WADA) + (size_t)k0 * 12288 + c0 + 4 * cl;
#pragma unroll 7
        for (int r = rg; r < 1024; r += 21) { const f32x4 w = *(const f32x4*)(wp + (size_t)r * 12288); a0 += w * sv[r]; a1 += w * sv[1024 + r]; a2 += w * sv[2048 + r]; }
        *(LAS f32x4*)(red + (rg * 3 + 0) * 96 + 4 * cl) = a0; *(LAS f32x4*)(red + (rg * 3 + 1) * 96 + 4 * cl) = a1; *(LAS f32x4*)(red + (rg * 3 + 2) * 96 + 4 * cl) = a2;
    }
    __syncthreads();
    if (tid < 288) { const int j = tid / 96, c = tid % 96; float s = 0.f;
        for (int g = 0; g < 21; ++g) s += red[(g * 3 + j) * 96 + c];
        __hip_atomic_store((float*)(F.wsp() + WS_MODP) + kh * 3 * 12288 + j * 12288 + c0 + c, s, __ATOMIC_RELAXED, __HIP_MEMORY_SCOPE_AGENT); }
    asm volatile("s_waitcnt vmcnt(0)" ::: "memory");
    __syncthreads();
    if (tid == 0) __hip_atomic_fetch_add((unsigned*)(F.wsp() + WS_CTL) + CW_ADA, 1u, __ATOMIC_RELAXED, __HIP_MEMORY_SCOPE_AGENT);
}

struct W3Frag { f32x4 w[2][8]; };
__device__ __forceinline__ void filt_w3_issue(W3Frag& f, const float* p) {
#pragma unroll
    for (int ks = 0; ks < 2; ++ks)
#pragma unroll
        for (int jj = 0; jj < 8; ++jj) f.w[ks][jj] = *(const f32x4*)(p + (size_t)(32 * ks + jj) * 4096);
}
__device__ __forceinline__ void filt_out(const W3Frag& f, const bf16x8 (&ah)[2], const bf16x8 (&al)[2], const f32x4 b3, const f32x4 dec, float* fo, int L, const float (&tn)[4]) {
#pragma unroll
    for (int e = 0; e < 4; ++e) { f32x4 acc = {0.f, 0.f, 0.f, 0.f};
#pragma unroll
        for (int ks = 0; ks < 2; ++ks) { u32x4 hi, lo;
#pragma unroll
            for (int p = 0; p < 4; ++p) { const float x0 = f.w[ks][2 * p][e], x1 = f.w[ks][2 * p + 1][e]; const unsigned h = pk2(x0, x1); hi[p] = h; lo[p] = pk2(x0 - bflo(h), x1 - bfhi(h)); }
            const bf16x8 bh = __builtin_bit_cast(bf16x8, hi), bl = __builtin_bit_cast(bf16x8, lo);
            acc = __builtin_amdgcn_mfma_f32_16x16x32_bf16(ah[ks], bh, acc, 0, 0, 0);
            acc = __builtin_amdgcn_mfma_f32_16x16x32_bf16(al[ks], bh, acc, 0, 0, 0);
            acc = __builtin_amdgcn_mfma_f32_16x16x32_bf16(ah[ks], bl, acc, 0, 0, 0); }
        f32x4 o;
#pragma unroll
        for (int i = 0; i < 4; ++i) o[i] = (acc[i] + b3[e]) * __expf(-tn[i] * fabsf(dec[e]));
        *(f32x4*)(fo + (size_t)e * L) = o; }
}
__device__ __forceinline__ void filt_item(const Ctx& F0, int v, int ch, int cq) {
    const Ctx F = fresh(F0);
    const int L = v ? LS : LP, t0 = 16 * ch, tid = F.tid, lane = F.lane, wave = F.wave;
    LAS float* zf = (LAS float*)F.lds;
    LAS float* h1 = zf + 16 * 36;
    LAS bf16_t* hh = (LAS bf16_t*)(h1 + 16 * 64);
    LAS float* w1s = h1 + 16 * 64 + 16 * 72;
    LAS float* w2s = w1s + 33 * 64;
    const int tt = tid >> 6, j = tid & 63, n = lane & 15, g = lane >> 4;
    const int col0 = 1024 * cq + 128 * wave + 4 * n;
    const f32x4 w2a = ((const f32x4*)F.inp(I_HYW2))[tid], w2b = ((const f32x4*)F.inp(I_HYW2))[tid + NTHREADS];
    const f32x4 w1a = ((const f32x4*)F.inp(I_HYW1))[tid]; f32x4 w1b = {0.f, 0.f, 0.f, 0.f};
    if (tid < 33 * 16 - NTHREADS) w1b = ((const f32x4*)F.inp(I_HYW1))[tid + NTHREADS];
    const float b1 = F.inp(I_HYB1)[j], fr1 = F.inp(I_HYFREQ)[j], b2 = F.inp(I_HYB2)[j], fr2 = F.inp(I_HYFREQ)[64 + j];
    const f32x4 b3a = *(const f32x4*)(F.inp(I_HYB3) + col0), b3b = *(const f32x4*)(F.inp(I_HYB3) + col0 + 64);
    const f32x4 dca = *(const f32x4*)(F.inp(I_HYDECAY) + col0), dcb = *(const f32x4*)(F.inp(I_HYDECAY) + col0 + 64);
    const float* w3p = F.inp(I_HYW3) + (size_t)(8 * g) * 4096 + col0;
    W3Frag fa; filt_w3_issue(fa, w3p);
    for (int e = tid; e < 16 * 33; e += NTHREADS) { const int te = e / 33, i = e % 33; const float nn = (float)(t0 + te); const float tn = nn / (float)L; const float w = 6.283185307179586f * nn / (float)L;
        float z;
        if (i == 0) z = tn; else { const int fi = (i - 1) & 15; const float f = 1e-4f + (float)fi * ((15.0f - 1e-4f) / 15.0f); z = (i <= 16) ? __cosf(w * f) : __sinf(w * f); }
        zf[te * 36 + i] = z; }
    *(LAS f32x4*)(w2s + 4 * tid) = w2a; *(LAS f32x4*)(w2s + 4 * (tid + NTHREADS)) = w2b;
    *(LAS f32x4*)(w1s + 4 * tid) = w1a; if (tid < 33 * 16 - NTHREADS) *(LAS f32x4*)(w1s + 4 * (tid + NTHREADS)) = w1b;
    __syncthreads();
    { float a0 = b1, a1 = b1;
#pragma unroll
      for (int i = 0; i < 33; ++i) { const float w = w1s[i * 64 + j]; a0 += zf[tt * 36 + i] * w; a1 += zf[(tt + 8) * 36 + i] * w; }
      h1[tt * 64 + j] = __sinf(fr1 * a0); h1[(tt + 8) * 64 + j] = __sinf(fr1 * a1); }
    W3Frag fb; filt_w3_issue(fb, w3p + 64);
    __syncthreads();
    { float a0 = b2, a1 = b2;
#pragma unroll
      for (int i = 0; i < 64; i += 4) { const f32x4 x = *(const LAS f32x4*)(h1 + tt * 64 + i), y = *(const LAS f32x4*)(h1 + (tt + 8) * 64 + i);
#pragma unroll
          for (int k = 0; k < 4; ++k) { const float w = w2s[(i + k) * 64 + j]; a0 += x[k] * w; a1 += y[k] * w; } }
      const float s0 = __sinf(fr2 * a0), s1 = __sinf(fr2 * a1);
      const unsigned hp = pk2(s0, s1); const unsigned lp = pk2(s0 - bflo(hp), s1 - bfhi(hp));
      hh[tt * 72 + j] = (bf16_t)(hp & 0xffffu); hh[(tt + 8) * 72 + j] = (bf16_t)(hp >> 16);
      hh[16 * 72 + tt * 72 + j] = (bf16_t)(lp & 0xffffu); hh[16 * 72 + (tt + 8) * 72 + j] = (bf16_t)(lp >> 16); }
    __syncthreads();
    { bf16x8 ah[2], al[2];
#pragma unroll
      for (int ks = 0; ks < 2; ++ks) { ah[ks] = *(const LAS bf16x8*)(hh + n * 72 + 32 * ks + 8 * g); al[ks] = *(const LAS bf16x8*)(hh + 16 * 72 + n * 72 + 32 * ks + 8 * g); }
      float tn[4];
#pragma unroll
      for (int i = 0; i < 4; ++i) tn[i] = (float)(t0 + 4 * g + i) / (float)L;
      float* fo = (float*)((unsigned char*)F.outp() + (v ? OUT_F1024 : OUT_F256)) + (size_t)col0 * L + t0 + 4 * g;
      filt_out(fa, ah, al, b3a, dca, fo, L, tn);
      filt_out(fb, ah, al, b3b, dcb, fo + (size_t)64 * L, L, tn); }
    __syncthreads();
}

__device__ __forceinline__ void phase_A(const Ctx& F) {
    if ((blockIdx.x & 1) == 0) { for (int it = F.vcu; it < 256; it += F.G) ada_item(F, it); }
    for (int it = F.vcu; it < 320; it += F.G) { const int ch = it >> 2, cq = it & 3; filt_item(F, ch >= 16, ch < 16 ? ch : ch - 16, cq); }
    if ((blockIdx.x & 1) != 0) { for (int it = F.vcu; it < 256; it += F.G) ada_item(F, it); }
    const int gw = F.vcu * NWAVES + F.wave, NGW = F.G * NWAVES;
    constexpr int I_IN = (DM / 64) * (NIN / 64), I_OUT = (DM / 64) * (DM / 64), I_BR = (DHY / 64) * (DM / 64);
    constexpr int NITEMS = I_IN + I_OUT + 2 * I_BR;
#pragma unroll 1
    for (int it = gw; it < NITEMS; it += NGW) {
        int r = it;
        if (r < I_IN) { transpose_item(F.inp(I_WIN), DM, NIN, (bf16_t*)((unsigned char*)F.outp() + OUT_WIN), r, F.lane); continue; } r -= I_IN;
        if (r < I_OUT) { transpose_item(F.inp(I_WOUT), DM, DM, (bf16_t*)(F.wsp() + WS_WOUT), r, F.lane); continue; } r -= I_OUT;
        if (r < I_BR) { transpose_item(F.inp(I_WBRH), DHY, DM, (bf16_t*)(F.wsp() + WS_WBRH), r, F.lane); continue; } r -= I_BR;
        transpose_item(F.inp(I_WBRR), DHY, DM, (bf16_t*)(F.wsp() + WS_WBRR), r, F.lane);
    }
    {
        if (F.tid == 0) { unsigned* cw_ = (unsigned*)(F.wsp() + WS_CTL) + CW_ADA; unsigned sp = 0;
            while (__hip_atomic_load(cw_, __ATOMIC_RELAXED, __HIP_MEMORY_SCOPE_AGENT) < 256u && ++sp < (1u << 22)) __builtin_amdgcn_s_sleep(2);
            __builtin_amdgcn_fence(__ATOMIC_ACQUIRE, "agent"); asm volatile("s_waitcnt vmcnt(0)" ::: "memory"); }
        __syncthreads();
        float* mc = (float*)(F.wsp() + WS_MODC);
        for (int e = F.vcu * NTHREADS + F.tid; e < 3 * 6 * DM; e += F.G * NTHREADS) { const int mv = e / (6 * DM), kind = (e / DM) % 6, c = e % DM; float v;
            const float* mp = (const float*)(F.wsp() + WS_MODP); const float* ba = F.inp(I_BADA);
            auto mod = [&](int idx) { return __hip_atomic_load(mp + mv * 12288 + idx, __ATOMIC_RELAXED, __HIP_MEMORY_SCOPE_AGENT) + __hip_atomic_load(mp + 3 * 12288 + mv * 12288 + idx, __ATOMIC_RELAXED, __HIP_MEMORY_SCOPE_AGENT) + ba[idx]; };
            if (kind == MC_AM) v = F.inp(I_NPREM)[c] * (1.0f + mod(DM + c)); else if (kind == MC_BM) v = mod(c); else if (kind == MC_GM) v = mod(2 * DM + c) * F.inp(I_NPOSTM)[c];
            else if (kind == MC_AF) v = F.inp(I_NPREF)[c] * (1.0f + mod(4 * DM + c)); else if (kind == MC_BF) v = mod(3 * DM + c); else v = mod(5 * DM + c) * F.inp(I_NPOSTF)[c];
            mc[e] = v; }
    }
}
__device__ __forceinline__ void late_transposes(const Ctx& F, int bi, int nb) {
    const int gw = bi * NWAVES + F.wave, NGW = nb * NWAVES;
    constexpr int I_UP = (DM / 64) * (NIN / 64), I_DN = (DFF / 64) * (DM / 64);
#pragma unroll 1
    for (int it = gw; it < I_UP + I_DN; it += NGW) {
        if (it < I_UP) transpose_item<true>(F.inp(I_WUP), DM, NIN, (bf16_t*)(F.wsp() + WS_WUP), it, F.lane);
        else transpose_item(F.inp(I_WDOWN), DFF, DM, (bf16_t*)(F.wsp() + WS_WDOWN), it - I_UP, F.lane);
    }
}

__device__ __forceinline__ void phase_B(const Ctx& F) {
    LAS float* Am = (LAS float*)F.lds;
    LAS float* Bm = Am + 3 * DM;
    { const float* mc = (const float*)(F.wsp() + WS_MODC);
      for (int i = F.tid; i < 3 * DM; i += NTHREADS) { const int mv = i >> 11, c = i & 2047; Am[i] = mc[(mv * 6 + MC_AM) * DM + c]; Bm[i] = mc[(mv * 6 + MC_BM) * DM + c]; } }
    __syncthreads();
    const int gw = F.vcu * NWAVES + F.wave, NGW = F.G * NWAVES;
    bf16_t* H = (bf16_t*)(F.wsp() + WS_R1);
    for (int r = gw; r < TT; r += NGW) {
        const int mv = row_mv(r); const f32x4* xr = (const f32x4*)x_row(F, r) + F.lane;
        f32x4 v[8]; float ss = 0.f;
#pragma unroll
        for (int j = 0; j < 8; ++j) { v[j] = xr[64 * j]; ss += (v[j].x * v[j].x + v[j].y * v[j].y) + (v[j].z * v[j].z + v[j].w * v[j].w); }
        const float rstd = rsqrtf(wave_sum(ss) * (1.0f / DM) + 1e-6f);
        u32x2* o = (u32x2*)(H + (size_t)r * DM) + F.lane;
#pragma unroll
        for (int j = 0; j < 8; ++j) { const int c = 4 * F.lane + 256 * j; const f32x4 a = *(const LAS f32x4*)(Am + mv * DM + c), b = *(const LAS f32x4*)(Bm + mv * DM + c);
            const f32x4 h = v[j] * rstd * a + b; u32x2 w; w.x = pk2(h.x, h.y); w.y = pk2(h.z, h.w); o[64 * j] = w; }
    }
    __syncthreads();
}

__device__ __forceinline__ void unpack8(const u32x4 a, float (&x)[8]) { x[0] = bflo(a.x); x[1] = bfhi(a.x); x[2] = bflo(a.y); x[3] = bfhi(a.y); x[4] = bflo(a.z); x[5] = bfhi(a.z); x[6] = bflo(a.w); x[7] = bfhi(a.w); }
constexpr int RT_BYTES = 128 * 256;
__device__ __forceinline__ unsigned off_b(unsigned row, unsigned ch) { return 256u * row + 16u * (ch ^ (((row & 3u) << 2) | ((row >> 2) & 3u))); }
__device__ __forceinline__ bf16x8 frag_row(const LAS unsigned char* tile, int rowbase, int lane, int s) { return *(const LAS bf16x8*)(tile + off_b((unsigned)(rowbase + (lane & 31)), (unsigned)(2 * s + (lane >> 5)))); }
typedef short s16x4 __attribute__((ext_vector_type(4)));
template <bool PERM>
__device__ __forceinline__ bf16x8 frag_tr(const LAS unsigned char* tile, int r0, int c, int lane) {
    const unsigned h = lane >> 5, blk = (lane >> 4) & 1, q = (lane & 15) >> 2, p = lane & 3;
    s16x4 v[2];
#pragma unroll
    for (int tp = 0; tp < 2; ++tp) { const unsigned row = (unsigned)r0 + (PERM ? 8u * tp + 4u * h : 8u * h + 4u * tp) + q;
        v[tp] = __builtin_amdgcn_ds_read_tr16_b64_v4i16((LAS s16x4*)(tile + off_b(row, 4u * c + 2u * blk + (p >> 1)) + 8u * (p & 1))); }
    bf16x8 r; r[0] = v[0][0]; r[1] = v[0][1]; r[2] = v[0][2]; r[3] = v[0][3]; r[4] = v[1][0]; r[5] = v[1][1]; r[6] = v[1][2]; r[7] = v[1][3]; return r;
}
struct RowPref { u32x4 lo[2], hi[2]; };
__device__ __forceinline__ void rows_issue(RowPref& p, const bf16_t* src, int tid) {
#pragma unroll
    for (int k = 0; k < 2; ++k) { const int task = tid + NTHREADS * k, r = task >> 3, ch = task & 7; p.lo[k] = *(const u32x4*)(src + (size_t)r * NPJ + 8 * ch); p.hi[k] = *(const u32x4*)(src + (size_t)r * NPJ + 64 + 8 * ch); }
}
template <class RW>
__device__ __forceinline__ void rows_store(const RowPref& p, LAS unsigned char* tile, int tid, bool rope, int t0, float scale, const float (&inv8)[8], RW rw) {
#pragma unroll
    for (int k = 0; k < 2; ++k) { const int task = tid + NTHREADS * k, r = task >> 3, ch = task & 7; const float sc = scale * rw(r);
        float x1[8], x2[8], o1[8], o2[8]; unpack8(p.lo[k], x1); unpack8(p.hi[k], x2);
        if (rope) { const int t = t0 + r; const float pos = (float)(ch < 4 ? (t >> 6) : (t & 63));
#pragma unroll
            for (int j = 0; j < 8; ++j) { const float rev = pos * inv8[j]; const float c = __builtin_amdgcn_cosf(rev) * sc, sn = __builtin_amdgcn_sinf(rev) * sc; o1[j] = x1[j] * c - x2[j] * sn; o2[j] = x2[j] * c + x1[j] * sn; }
        } else {
#pragma unroll
            for (int j = 0; j < 8; ++j) { o1[j] = x1[j] * sc; o2[j] = x2[j] * sc; }
        }
        u32x4 w1, w2; w1.x = pk2(o1[0], o1[1]); w1.y = pk2(o1[2], o1[3]); w1.z = pk2(o1[4], o1[5]); w1.w = pk2(o1[6], o1[7]);
        w2.x = pk2(o2[0], o2[1]); w2.y = pk2(o2[2], o2[3]); w2.z = pk2(o2[4], o2[5]); w2.w = pk2(o2[6], o2[7]);
        *(LAS u32x4*)(tile + off_b(r, ch)) = w1; *(LAS u32x4*)(tile + off_b(r, ch + 8)) = w2; }
}
struct One { __device__ __forceinline__ float operator()(int) const { return 1.0f; } };

struct RetPref { RowPref q, k, v; };
__device__ __forceinline__ void ret_issue(RetPref& p, const Ctx& F, int bg, int h, int qt) {
    const bool smp = bg >= 32; const int rowb = smp ? TP + (bg - 32) * LS : bg * LP; const bf16_t* proj = (const bf16_t*)(F.wsp() + WS_PROJ);
    rows_issue(p.q, proj + (size_t)(rowb + qt * 128) * NPJ + O_Q + h * HD, F.tid); rows_issue(p.k, proj + (size_t)rowb * NPJ + O_K + h * HD, F.tid); rows_issue(p.v, proj + (size_t)rowb * NPJ + O_V + h * HD, F.tid);
}
__device__ __forceinline__ void ret_item(const Ctx& F0, RetPref& pf, int bg, int h, int qt, bool has_next, int nbg, int nh, int nqt) {
    const Ctx F = fresh(F0);
    const bool smp = bg >= 32; const int L = smp ? LS : LP; const int rowb = smp ? TP + (bg - 32) * LS : bg * LP;
    const bf16_t* proj = (const bf16_t*)(F.wsp() + WS_PROJ);
    LAS unsigned char* Qs = F.lds; LAS unsigned char* Ks = Qs + RT_BYTES; LAS unsigned char* Vs = Ks + RT_BYTES;
    const int wm = F.wave >> 1, wn = F.wave & 1, tid = F.tid; int lane = F.lane;
    const float gf = sigmoidf_(F.inp(I_RETLOGIT)[h]), gb = sigmoidf_(F.inp(I_RETLOGIT)[NH + h]); const float lgf = __log2f(gf), lgb = __log2f(gb);
    const float kscale = 0.08838834764831845f;
    float inv8[8];
#pragma unroll
    for (int j = 0; j < 8; ++j) inv8[j] = exp2f(-(float)((8 * (tid & 7) + j) & 31) * 0.41524101186092029f) * 0.15915494309189535f;
    const bf16_t* kbase = proj + (size_t)rowb * NPJ + O_K + h * HD; const bf16_t* vbase = proj + (size_t)rowb * NPJ + O_V + h * HD;
    RowPref& kp = pf.k; RowPref& vp = pf.v;
    rows_store(pf.q, Qs, tid, smp, qt * 128, 1.0f, inv8, One());
    f32x16 oacc[4];
#pragma unroll
    for (int c = 0; c < 4; ++c) oacc[c] = (f32x16){};
    const int nkb = L / 128;
#pragma unroll 1
    for (int kb = 0; kb < nkb; ++kb) {
        rows_store(kp, Ks, tid, smp, kb * 128, kscale, inv8, One());
        rows_store(vp, Vs, tid, false, 0, 1.0f, inv8, One());
        __syncthreads();
        if (kb + 1 < nkb) { rows_issue(kp, kbase + (size_t)(kb + 1) * 128 * NPJ, tid); rows_issue(vp, vbase + (size_t)(kb + 1) * 128 * NPJ, tid); }
        asm volatile("" : "+v"(lane));
#pragma unroll
        for (int st = 0; st < 2; ++st) {
            const int s0 = 64 * wn + 32 * st;
            f32x16 x = (f32x16){};
#pragma unroll
            for (int k = 0; k < 8; ++k) x = __builtin_amdgcn_mfma_f32_32x32x16_bf16(frag_row(Ks, s0, lane, k), frag_row(Qs, 32 * wm, lane, k), x, 0, 0, 0);
            const int d0 = (qt * 128 + 32 * wm + (lane & 31)) - (kb * 128 + s0 + 4 * (lane >> 5));
            unsigned pk[8];
#pragma unroll
            for (int i = 0; i < 16; i += 2) { float v[2];
#pragma unroll
                for (int e = 0; e < 2; ++e) { const int diff = d0 - (((i + e) & 3) + 8 * ((i + e) >> 2));
                    const float d = diff > 0 ? __builtin_amdgcn_exp2f(lgf * (float)diff) : (diff < 0 ? __builtin_amdgcn_exp2f(lgb * (float)(-diff)) : 2.0f); v[e] = x[i + e] * d; }
                pk[i >> 1] = pk2(v[0], v[1]); }
#pragma unroll
            for (int ks2 = 0; ks2 < 2; ++ks2) {
                bf16x8 a; { u32x4 w; w.x = pk[4 * ks2]; w.y = pk[4 * ks2 + 1]; w.z = pk[4 * ks2 + 2]; w.w = pk[4 * ks2 + 3]; a = __builtin_bit_cast(bf16x8, w); }
#pragma unroll
                for (int c = 0; c < 4; ++c) oacc[c] = __builtin_amdgcn_mfma_f32_32x32x16_bf16(a, frag_tr<true>(Vs, s0 + 16 * ks2, c, lane), oacc[c], 0, 0, 0);
            }
        }
        __syncthreads();
    }
    if (smp) {
#pragma unroll 1
        for (int dir = 0; dir < 2; ++dir) {
            const float* st = F.inp(I_STATE) + ((size_t)((bg - 32) * 2 + dir) * NH + h) * HD * HD;
#pragma unroll
            for (int k = 0; k < 4; ++k) { const int e = tid + NTHREADS * k, r = e >> 4, ch = e & 15;
                const f32x4 a = *(const f32x4*)(st + r * HD + 8 * ch), b = *(const f32x4*)(st + r * HD + 8 * ch + 4);
                u32x4 w; w.x = pk2(a.x, a.y); w.y = pk2(a.z, a.w); w.z = pk2(b.x, b.y); w.w = pk2(b.z, b.w); *(LAS u32x4*)(Vs + off_b(r, ch)) = w;
                const int t = qt * 128 + r; const float sc = dir == 0 ? exp2f(lgf * (float)(t + 1)) : exp2f(lgb * (float)(L - t));
                const u32x4 q = *(const LAS u32x4*)(Qs + off_b(r, ch)); u32x4 z;
                z.x = pk2(bflo(q.x) * sc, bfhi(q.x) * sc); z.y = pk2(bflo(q.y) * sc, bfhi(q.y) * sc); z.z = pk2(bflo(q.z) * sc, bfhi(q.z) * sc); z.w = pk2(bflo(q.w) * sc, bfhi(q.w) * sc);
                *(LAS u32x4*)(Ks + off_b(r, ch)) = z; }
            __syncthreads();
#pragma unroll
            for (int ks = 0; ks < 4; ++ks) { const int kk = 4 * wn + ks; const bf16x8 a = frag_row(Ks, 32 * wm, lane, kk);
#pragma unroll
                for (int c = 0; c < 4; ++c) oacc[c] = __builtin_amdgcn_mfma_f32_32x32x16_bf16(a, frag_tr<false>(Vs, 16 * kk, c, lane), oacc[c], 0, 0, 0); }
            __syncthreads();
        }
    }
    { const int r = tid >> 2, qd = tid & 3;
      const size_t row = (size_t)(rowb + qt * 128 + r); const bf16_t* gp = proj + row * NPJ + O_G + h * HD + 32 * qd; const float* gnp = F.inp(I_RETGN) + h * HD + 32 * qd;
      u32x4 gq[4]; f32x4 gn[8];
#pragma unroll
      for (int j = 0; j < 4; ++j) gq[j] = *(const u32x4*)(gp + 8 * j);
#pragma unroll
      for (int j = 0; j < 8; ++j) gn[j] = *(const f32x4*)(gnp + 4 * j);
      if (has_next) ret_issue(pf, F, nbg, nh, nqt);
      LAS float* Os = (LAS float*)F.lds + wn * (128 * 132);
      { LAS float* op = Os + (32 * wm + 4 * (lane >> 5)) * 132 + (lane & 31);
#pragma unroll
        for (int c = 0; c < 4; ++c)
#pragma unroll
            for (int i = 0; i < 16; ++i) op[((i & 3) + 8 * (i >> 2)) * 132 + 32 * c] = oacc[c][i]; }
      __syncthreads();
      const LAS float* o0 = (const LAS float*)F.lds + r * 132 + 32 * qd; float v[32]; float s = 0.f;
#pragma unroll
      for (int j = 0; j < 8; ++j) { const f32x4 x = *(const LAS f32x4*)(o0 + 4 * j) + *(const LAS f32x4*)(o0 + 128 * 132 + 4 * j); v[4 * j] = x.x; v[4 * j + 1] = x.y; v[4 * j + 2] = x.z; v[4 * j + 3] = x.w; s += (x.x + x.y) + (x.z + x.w); }
      s += __shfl_xor(s, 1); s += __shfl_xor(s, 2); const float mu = s * (1.0f / 128.0f); float q = 0.f;
#pragma unroll
      for (int j = 0; j < 32; ++j) { v[j] -= mu; q += v[j] * v[j]; }
      q += __shfl_xor(q, 1); q += __shfl_xor(q, 2); const float rstd = rsqrtf(q * (1.0f / 128.0f) + 1e-5f);
      bf16_t* yo = (bf16_t*)(F.wsp() + WS_R1) + (size_t)TT * DHY + row * DHY + h * HD + 32 * qd;
#pragma unroll
      for (int j = 0; j < 4; ++j) { float gg[8]; unpack8(gq[j], gg); const float gw[8] = {gn[2 * j].x, gn[2 * j].y, gn[2 * j].z, gn[2 * j].w, gn[2 * j + 1].x, gn[2 * j + 1].y, gn[2 * j + 1].z, gn[2 * j + 1].w}; float o[8];
#pragma unroll
          for (int e = 0; e < 8; ++e) { const float gv = gg[e]; o[e] = v[8 * j + e] * rstd * gw[e] * (gv * __builtin_amdgcn_rcpf(1.0f + __expf(-gv))); }
          u32x4 w; w.x = pk2(o[0], o[1]); w.y = pk2(o[2], o[3]); w.z = pk2(o[4], o[5]); w.w = pk2(o[6], o[7]); *(u32x4*)(yo + 8 * j) = w; } }
    __syncthreads();
}
__device__ __forceinline__ void state_item(const Ctx& F0, int b, int h) {
    const Ctx F = fresh(F0);
    const bf16_t* proj = (const bf16_t*)(F.wsp() + WS_PROJ); const int rowb = b * LP;
    LAS unsigned char* Kf = F.lds; LAS unsigned char* Kb = Kf + RT_BYTES; LAS unsigned char* Vs = Kb + RT_BYTES;
    const int wm = F.wave >> 1, wn = F.wave & 1, lane = F.lane, tid = F.tid;
    const float gf = sigmoidf_(F.inp(I_RETLOGIT)[h]), gb = sigmoidf_(F.inp(I_RETLOGIT)[NH + h]); const float lgf = __log2f(gf), lgb = __log2f(gb);
    const float kscale = 0.08838834764831845f;
    float inv8[8];
#pragma unroll
    for (int j = 0; j < 8; ++j) inv8[j] = 0.f;
    f32x16 af[2], ab[2]; af[0] = (f32x16){}; af[1] = (f32x16){}; ab[0] = (f32x16){}; ab[1] = (f32x16){};
    const bf16_t* kbase = proj + (size_t)rowb * NPJ + O_K + h * HD; const bf16_t* vbase = proj + (size_t)rowb * NPJ + O_V + h * HD;
    RowPref kp, vp; rows_issue(kp, kbase, tid); rows_issue(vp, vbase, tid);
#pragma unroll 1
    for (int kb = 0; kb < LP / 128; ++kb) {
        rows_store(kp, Kf, tid, false, 0, kscale, inv8, [=](int r) { return exp2f(lgf * (float)(LP - 1 - (kb * 128 + r))); });
        rows_store(kp, Kb, tid, false, 0, kscale, inv8, [=](int r) { return exp2f(lgb * (float)(kb * 128 + r)); });
        rows_store(vp, Vs, tid, false, 0, 1.0f, inv8, One());
        __syncthreads();
        if (kb + 1 < LP / 128) { rows_issue(kp, kbase + (size_t)(kb + 1) * 128 * NPJ, tid); rows_issue(vp, vbase + (size_t)(kb + 1) * 128 * NPJ, tid); }
#pragma unroll 2
        for (int ks = 0; ks < 8; ++ks) {
            const bf16x8 a_f = frag_tr<false>(Kf, 16 * ks, wm, lane), a_b = frag_tr<false>(Kb, 16 * ks, wm, lane);
#pragma unroll
            for (int nt = 0; nt < 2; ++nt) { const bf16x8 bv = frag_tr<false>(Vs, 16 * ks, 2 * wn + nt, lane);
                af[nt] = __builtin_amdgcn_mfma_f32_32x32x16_bf16(a_f, bv, af[nt], 0, 0, 0); ab[nt] = __builtin_amdgcn_mfma_f32_32x32x16_bf16(a_b, bv, ab[nt], 0, 0, 0); }
        }
        __syncthreads();
    }
    float* so = (float*)((unsigned char*)F.outp() + OUT_STATE) + ((size_t)(b * 2 + 0) * NH + h) * HD * HD;
    float* sb = (float*)((unsigned char*)F.outp() + OUT_STATE) + ((size_t)(b * 2 + 1) * NH + h) * HD * HD;
    { const int o0 = (32 * wm + 4 * (lane >> 5)) * HD + 64 * wn + (lane & 31);
#pragma unroll
      for (int nt = 0; nt < 2; ++nt)
#pragma unroll
        for (int i = 0; i < 16; ++i) { so[o0 + ((i & 3) + 8 * (i >> 2)) * HD + 32 * nt] = af[nt][i]; sb[o0 + ((i & 3) + 8 * (i >> 2)) * HD + 32 * nt] = ab[nt][i]; } }
}

template <bool SMP> struct HyCfg {
    static constexpr int L = SMP ? LS : LP, CP = SMP ? 4160 : 1088  , PU = SMP ? 144 : 272  , NROW = SMP ? 17 : 32,
                         NCHK = SMP ? 16 : 32  , NTAP = 2 * L + 16, NK = (NTAP + NTHREADS - 1) / NTHREADS;
    static constexpr int OFF_U = 16 * CP, BUF = NROW * PU * 2, OFF_RED = OFF_U + 3 * BUF;
};
template <bool SMP>
__device__ __forceinline__ void hy_conv(f32x4 (&acc)[2][2], const LAS unsigned char* ft, const LAS bf16_t* Ub, int wave, int lane) {
    typedef HyCfg<SMP> C;
    const int row = lane & 15, g = lane >> 4;
    const LAS unsigned char* abase = ft + 16 + (7 - (row & 7)) * C::CP + (C::L - 8 - 8 * (row >> 3) + 8 * g) * 2;
    if constexpr (!SMP) {
#pragma unroll 2
        for (int ks = 0; ks < 8; ++ks) {
            bf16x8 b[2];
#pragma unroll
            for (int cg = 0; cg < 2; ++cg) b[cg] = *(const LAS bf16x8*)(Ub + (16 * cg + row) * C::PU + 32 * ks + 8 * g);
#pragma unroll
            for (int mi = 0; mi < 2; ++mi) { const int mt = 2 * wave + mi; const bf16x8 a = *(const LAS bf16x8*)(abase + (32 * ks - 16 * mt) * 2);
#pragma unroll
                for (int cg = 0; cg < 2; ++cg) acc[mi][cg] = __builtin_amdgcn_mfma_f32_16x16x32_bf16(a, b[cg], acc[mi][cg], 0, 0, 0); }
        }
    } else {
        const int mt = wave;
#pragma unroll 1
        for (int d = -7; d <= 7; ++d) {
            const int j = (row & 7) - d; const int brow = (j >= 0 && j < 8) ? (row & 8) + j : 16;
            const LAS bf16_t* bp = Ub + brow * C::PU + 8 * g; const LAS unsigned char* ap = abase + (-16 * mt - 128 * d) * 2;
#pragma unroll
            for (int ks = 0; ks < 4; ++ks) { const bf16x8 a = *(const LAS bf16x8*)(ap + 64 * ks); const bf16x8 b = *(const LAS bf16x8*)(bp + 32 * ks);
                acc[0][0] = __builtin_amdgcn_mfma_f32_16x16x32_bf16(a, b, acc[0][0], 0, 0, 0); }
        }
    }
}
template <bool SMP> struct HyPref {
    static constexpr int NCH = (SMP ? 16 : 32) * HyCfg<SMP>::NCHK, NIT = (NCH + NTHREADS - 1) / NTHREADS;
    float tv[2][HyCfg<SMP>::NK]; u32x4 raw[3][NIT]; unsigned hl[3][NIT], hr[3][NIT]; float sw[3][3], bias[2];
};
template <bool SMP>
__device__ __forceinline__ void hy_issue(HyPref<SMP>& p, const Ctx& F, int c) {
    typedef HyCfg<SMP> C; constexpr int L = C::L; const int tid = F.tid, lane = F.lane;
    const float* ftab = (const float*)((const unsigned char*)F.outp() + (SMP ? OUT_F1024 : OUT_F256));
#pragma unroll
    for (int ten = 0; ten < 3; ++ten)
#pragma unroll
        for (int k = 0; k < 3; ++k) p.sw[ten][k] = F.inp(I_HYSW)[k * 3072 + ten * 1024 + c];
#pragma unroll
    for (int o = 0; o < 2; ++o) { const float* fwd = ftab + (size_t)(o * 1024 + c) * L; const float* bwd = ftab + (size_t)(2048 + o * 1024 + c) * L;
        p.bias[o] = F.inp(I_HYBIAS)[o * 1024 + c];
#pragma unroll
        for (int k = 0; k < C::NK; ++k) { const int i = tid + NTHREADS * k;
            const int ia = i <= L - 1 ? L - 1 - i : (i <= 2 * L - 2 ? i - L + 1 : 0); const float* src = i <= L - 1 ? fwd : bwd;
            const float v = src[ia]; p.tv[o][k] = i <= 2 * L - 2 ? v : 0.f; } }
#pragma unroll
    for (int ten = 0; ten < 3; ++ten) {
        const bf16_t* pt = (const bf16_t*)(F.wsp() + (ten == 0 ? WS_X1T : (ten == 1 ? WS_X2T : WS_VT))) + (size_t)c * TT;
#pragma unroll
        for (int it = 0; it < HyPref<SMP>::NIT; ++it) { const int id = tid + NTHREADS * it; const int r = (id / C::NCHK) % (SMP ? 16 : 32), ci = id % C::NCHK;
            const int tseq = SMP ? (r & 7) * 128 + 8 * ci : 8 * ci;
            const size_t tok = SMP ? (size_t)TP + (size_t)(r >> 3) * LS + tseq : (size_t)r * LP + tseq;
            const bf16_t* src = pt + tok;
            p.raw[ten][it] = *(const u32x4*)src;
            p.hl[ten][it] = (unsigned)src[tseq > 0 ? -1 : 0]; p.hr[ten][it] = (unsigned)src[tseq + 8 < L ? 8 : 7]; } }
}
template <bool SMP>
__device__ __forceinline__ void hy_build(const HyPref<SMP>& p, const Ctx& F, int c) {
    typedef HyCfg<SMP> C; constexpr int L = C::L; const int tid = F.tid, lane = F.lane, wave = F.wave;
    LAS unsigned char* ft = F.lds;
    LAS bf16_t* Vb = (LAS bf16_t*)(F.lds + C::OFF_U); LAS bf16_t* X1 = Vb + C::NROW * C::PU; LAS bf16_t* X2 = X1 + C::NROW * C::PU;
    LAS float* red = (LAS float*)(F.lds + C::OFF_RED);
#pragma unroll
    for (int o = 0; o < 2; ++o) { float s = 0.f;
#pragma unroll
        for (int k = 0; k < C::NK; ++k) s += fabsf(p.tv[o][k]);
        s = wave_sum(s); if (lane == 0) red[o * 8 + wave] = s; }
#pragma unroll
    for (int ten = 0; ten < 3; ++ten) {
        const float w0 = p.sw[ten][0], w1 = p.sw[ten][1], w2 = p.sw[ten][2];
        LAS bf16_t* dst = ten == 0 ? X1 : (ten == 1 ? X2 : Vb);
#pragma unroll
        for (int it = 0; it < HyPref<SMP>::NIT; ++it) { const int id = tid + NTHREADS * it; const int r = (id / C::NCHK) % (SMP ? 16 : 32), ci = id % C::NCHK;
            const int tseq = SMP ? (r & 7) * 128 + 8 * ci : 8 * ci;
            float xc[8]; unpack8(p.raw[ten][it], xc);
            float xl = __shfl_up(xc[7], 1), xr = __shfl_down(xc[0], 1);
            if (lane == 0) xl = bf2f((bf16_t)p.hl[ten][it]); if (lane == 63) xr = bf2f((bf16_t)p.hr[ten][it]);
            if (tseq == 0) xl = 0.f; if (tseq + 8 >= L) xr = 0.f;
            float o[8];
            o[0] = w0 * xl + w1 * xc[0] + w2 * xc[1];
#pragma unroll
            for (int j = 1; j < 7; ++j) o[j] = w0 * xc[j - 1] + w1 * xc[j] + w2 * xc[j + 1];
            o[7] = w0 * xc[6] + w1 * xc[7] + w2 * xr;
            u32x4 w; w.x = pk2(o[0], o[1]); w.y = pk2(o[2], o[3]); w.z = pk2(o[4], o[5]); w.w = pk2(o[6], o[7]);
            if (id < HyPref<SMP>::NCH) *(LAS u32x4*)(dst + r * C::PU + 8 * ci) = w; } }
    if (SMP) { for (int i = tid; i < 2 * C::PU; i += NTHREADS) { if (i < C::PU) Vb[16 * C::PU + i] = 0; else X1[16 * C::PU + i - C::PU] = 0; } }
    __syncthreads();
#pragma unroll
    for (int o = 0; o < 2; ++o) { float tot = 0.f;
#pragma unroll
        for (int w = 0; w < 8; ++w) tot += red[o * 8 + w];
        const float inv = 1.0f / (tot + 1e-6f); const float bias = p.bias[o];
        LAS bf16_t* fo = (LAS bf16_t*)(ft + o * 8 * C::CP) + 8;
#pragma unroll
        for (int k = 0; k < C::NK; ++k) { const int i = tid + NTHREADS * k;
            if (i < C::NTAP) { const bf16_t w = (bf16_t)f2bf(p.tv[o][k] * inv + (i == L - 1 ? bias : 0.f));
#pragma unroll
                for (int m = 0; m < 8; ++m) fo[m * (C::CP / 2) + i - m] = w; } } }
    __syncthreads();
}
template <bool SMP>
__device__ __forceinline__ void hy_compute(const Ctx& F, unsigned long long (&yb)[SMP ? 4 : 16]) {
    typedef HyCfg<SMP> C; const int lane = F.lane, wave = F.wave;
    LAS unsigned char* ft = F.lds;
    LAS bf16_t* Vb = (LAS bf16_t*)(F.lds + C::OFF_U); LAS bf16_t* X1 = Vb + C::NROW * C::PU; LAS bf16_t* X2 = X1 + C::NROW * C::PU;
    const int n = lane & 15, g = lane >> 4;
    constexpr int NMI = SMP ? 1 : 2, NCG = SMP ? 1 : 2;
    { f32x4 acc[2][2]; acc[0][0] = acc[0][1] = acc[1][0] = acc[1][1] = (f32x4){0.f, 0.f, 0.f, 0.f};
      hy_conv<SMP>(acc, ft, Vb, wave, lane);
#pragma unroll
      for (int mi = 0; mi < NMI; ++mi)
#pragma unroll
          for (int cg = 0; cg < NCG; ++cg) { const int mt = SMP ? wave : 2 * wave + mi; LAS bf16_t* p = X1 + (16 * cg + n) * C::PU + 16 * mt + 4 * g;
              const u32x2 xv = *(const LAS u32x2*)p; u32x2 w; w.x = pk2(bflo(xv.x) * acc[mi][cg][0], bfhi(xv.x) * acc[mi][cg][1]); w.y = pk2(bflo(xv.y) * acc[mi][cg][2], bfhi(xv.y) * acc[mi][cg][3]);
              *(LAS u32x2*)p = w; } }
    __syncthreads();
    { f32x4 acc[2][2]; acc[0][0] = acc[0][1] = acc[1][0] = acc[1][1] = (f32x4){0.f, 0.f, 0.f, 0.f};
      hy_conv<SMP>(acc, ft + 8 * C::CP, X1, wave, lane);
#pragma unroll
      for (int mi = 0; mi < NMI; ++mi)
#pragma unroll
          for (int cg = 0; cg < NCG; ++cg) { const int mt = SMP ? wave : 2 * wave + mi; const int tl = 16 * mt + 4 * g;
              const u32x2 xv = *(const LAS u32x2*)(X2 + (16 * cg + n) * C::PU + tl);
              const float y[4] = {bflo(xv.x) * acc[mi][cg][0], bfhi(xv.x) * acc[mi][cg][1], bflo(xv.y) * acc[mi][cg][2], bfhi(xv.y) * acc[mi][cg][3]};
#pragma unroll
              for (int e = 0; e < 4; ++e) { unsigned long long& q = yb[(mi * NCG + cg) * 4 + e]; q = (q >> 16) | ((unsigned long long)f2bf(y[e]) << 48); } } }
    __syncthreads();
}
template <bool SMP>
__device__ __forceinline__ void hy_store(const Ctx& F, const unsigned long long (&yb)[SMP ? 4 : 16], int c0) {
    const int lane = F.lane, wave = F.wave, n = lane & 15, g = lane >> 4;
    constexpr int NMI = SMP ? 1 : 2, NCG = SMP ? 1 : 2;
    bf16_t* Y = (bf16_t*)(F.wsp() + WS_R1);
#pragma unroll
    for (int mi = 0; mi < NMI; ++mi)
#pragma unroll
        for (int cg = 0; cg < NCG; ++cg) { const int mt = SMP ? wave : 2 * wave + mi; const int tl = 16 * mt + 4 * g;
            const size_t tok = SMP ? (size_t)TP + (size_t)(n >> 3) * LS + (n & 7) * 128 + tl : (size_t)(16 * cg + n) * LP + tl;
#pragma unroll
            for (int e = 0; e < 4; ++e) *(unsigned long long*)(Y + (tok + e) * DHY + c0) = yb[(mi * NCG + cg) * 4 + e]; }
}
template <bool SMP>
__device__ __forceinline__ void hyena_items(const Ctx& F0) {
    const Ctx F = fresh(F0);
    HyPref<SMP> p0, p1; unsigned long long yb[SMP ? 4 : 16];
#pragma unroll 1
    for (int c0 = 4 * F.vcu; c0 < DHY; c0 += 4 * F.G) {
        hy_issue<SMP>(p0, F, c0); hy_issue<SMP>(p1, F, c0 + 1);
        hy_build<SMP>(p0, F, c0);     hy_issue<SMP>(p0, F, c0 + 2); hy_compute<SMP>(F, yb);
        hy_build<SMP>(p1, F, c0 + 1); hy_issue<SMP>(p1, F, c0 + 3); hy_compute<SMP>(F, yb);
        hy_build<SMP>(p0, F, c0 + 2); hy_compute<SMP>(F, yb);
        hy_build<SMP>(p1, F, c0 + 3); hy_compute<SMP>(F, yb);
        { const Ctx Fq = fresh(F0); hy_store<SMP>(Fq, yb, c0); }
    }
}

__device__ __forceinline__ void phase_D(const Ctx& F) {
    for (int v = F.vcu; v < 256; v += F.G) {
        RetPref pf;
        if (v < 128) { const int bg = 32 + (v >> 6), h = (v >> 3) & 7, qt = v & 7; ret_issue(pf, F, bg, h, qt); ret_item(F, pf, bg, h, qt, false, 0, 0, 0); }
        else { const int j0 = 4 * (v - 128); ret_issue(pf, F, j0 >> 4, (j0 >> 1) & 7, j0 & 1);
#pragma unroll 1
            for (int k = 0; k < 4; ++k) { const int j = j0 + k, jn = j + 1; ret_item(F, pf, j >> 4, (j >> 1) & 7, j & 1, k < 3, jn >> 4, (jn >> 1) & 7, jn & 1); } }
    }
    for (int j = F.vcu; j < 256; j += F.G) { state_item(F, j >> 3, j & 7); __syncthreads(); }
    hyena_items<true>(F);
    hyena_items<false>(F);
}

__device__ __forceinline__ void phase_G(const Ctx& F) {
    LAS float* Gm = (LAS float*)F.lds; LAS float* Af = Gm + 3 * DM; LAS float* Bf = Af + 3 * DM;
    { const float* mc = (const float*)(F.wsp() + WS_MODC);
      for (int i = F.tid; i < 3 * DM; i += NTHREADS) { const int mv = i >> 11, c = i & 2047; Gm[i] = mc[(mv * 6 + MC_GM) * DM + c]; Af[i] = mc[(mv * 6 + MC_AF) * DM + c]; Bf[i] = mc[(mv * 6 + MC_BF) * DM + c]; } }
    __syncthreads();
    const int gw = F.vcu * NWAVES + F.wave, NGW = F.G * NWAVES;
    const bf16_t* M = (const bf16_t*)(F.wsp() + WS_PROJ); bf16_t* H2 = (bf16_t*)(F.wsp() + WS_R1);
    for (int r = gw; r < TT; r += NGW) {
        const int mv = row_mv(r); const u32x2* mr = (const u32x2*)(M + (size_t)r * DM) + F.lane; const f32x4* xr = (const f32x4*)x_row(F, r) + F.lane;
        f32x4 v[8], xv[8]; float ss = 0.f;
#pragma unroll
        for (int j = 0; j < 8; ++j) xv[j] = xr[64 * j];
        if (r >= TP) { const u32x2* sp = mr + ((size_t)TT * DM - (size_t)TP * DM) / 4;
            u32x2 q0[8], q1[8], q2[8], q3[8];
#pragma unroll
            for (int j = 0; j < 8; ++j) { q0[j] = mr[64 * j]; q1[j] = sp[64 * j]; q2[j] = sp[64 * j + (size_t)TSM * DM / 4]; q3[j] = sp[64 * j + 2 * (size_t)TSM * DM / 4]; }
#pragma unroll
            for (int j = 0; j < 8; ++j) v[j] = (bf4(q0[j]) + bf4(q1[j])) + (bf4(q2[j]) + bf4(q3[j]));
        } else { u32x2 q0[8];
#pragma unroll
            for (int j = 0; j < 8; ++j) q0[j] = mr[64 * j];
#pragma unroll
            for (int j = 0; j < 8; ++j) v[j] = bf4(q0[j]); }
#pragma unroll
        for (int j = 0; j < 8; ++j) ss += (v[j].x * v[j].x + v[j].y * v[j].y) + (v[j].z * v[j].z + v[j].w * v[j].w);
        const float rstd = rsqrtf(wave_sum(ss) * (1.0f / DM) + 1e-6f); float s1 = 0.f;
        f32x4* xo = (f32x4*)(F.outp() + (size_t)r * DM) + F.lane;
#pragma unroll
        for (int j = 0; j < 8; ++j) { const int c = 4 * F.lane + 256 * j; const f32x4 g = *(const LAS f32x4*)(Gm + mv * DM + c);
            const f32x4 x1 = xv[j] + g * (v[j] * rstd); v[j] = x1; s1 += (x1.x * x1.x + x1.y * x1.y) + (x1.z * x1.z + x1.w * x1.w); }
#pragma unroll
        for (int j = 0; j < 8; ++j) xo[64 * j] = v[j];
        const float rstd1 = rsqrtf(wave_sum(s1) * (1.0f / DM) + 1e-6f);
        u32x2* o = (u32x2*)(H2 + (size_t)r * DM) + F.lane;
#pragma unroll
        for (int j = 0; j < 8; ++j) { const int c = 4 * F.lane + 256 * j; const f32x4 a = *(const LAS f32x4*)(Af + mv * DM + c), b = *(const LAS f32x4*)(Bf + mv * DM + c);
            const f32x4 h = v[j] * rstd1 * a + b; u32x2 w; w.x = pk2(h.x, h.y); w.y = pk2(h.z, h.w); o[64 * j] = w; }
    }
    __syncthreads();
}

__device__ __forceinline__ void phase_I(const Ctx& F) {
    const bf16_t* UE = (const bf16_t*)(F.wsp() + WS_UE); bf16_t* ACT = (bf16_t*)(F.wsp() + WS_ACT2); const float* cw = F.inp(I_FFNCONV);
    const int gid = F.vcu * NTHREADS + F.tid, nth = F.G * NTHREADS;
    constexpr int NCG = DFF / 8, NROWS = (TT / 256) * 8, NTASK = NROWS * NCG;
    for (int task = gid; task < NTASK; task += nth) {
        const int ri = task / NCG, cg = task - ri * NCG, c0 = cg * 8;
        const int pm = ri >> 3, strip = (ri >> 1) & 3, e = ri & 1;
        const int r = 64 * strip + (e ? 63 : 0), g = pm * 256 + r;
        const bool smp = g >= TP; const int t = smp ? ((g - TP) & (LS - 1)) : r; const int L = smp ? LS : LP;
        auto ue = [&](int tile, int st, int w, int ab) { return UE + ((size_t)((tile * 4 + st) * 4 + w) * 2 + ab) * DFF + c0; };
        float am[8], ac[8], ap[8], bm[8], bc[8], bp[8];
        unpack8(*(const u32x4*)ue(pm, strip, e ? 3 : 0, 0), ac); unpack8(*(const u32x4*)ue(pm, strip, e ? 3 : 0, 1), bc);
        if (e) { unpack8(*(const u32x4*)ue(pm, strip, 2, 0), am); unpack8(*(const u32x4*)ue(pm, strip, 2, 1), bm); }
        else if (t > 0) { const int tp = strip > 0 ? pm : pm - 1, sp = strip > 0 ? strip - 1 : 3; unpack8(*(const u32x4*)ue(tp, sp, 3, 0), am); unpack8(*(const u32x4*)ue(tp, sp, 3, 1), bm); }
        else {
#pragma unroll
            for (int j = 0; j < 8; ++j) { am[j] = 0.f; bm[j] = 0.f; } }
        if (!e) { unpack8(*(const u32x4*)ue(pm, strip, 1, 0), ap); unpack8(*(const u32x4*)ue(pm, strip, 1, 1), bp); }
        else if (t + 1 < L) { const int tn = strip < 3 ? pm : pm + 1, sn = strip < 3 ? strip + 1 : 0; unpack8(*(const u32x4*)ue(tn, sn, 0, 0), ap); unpack8(*(const u32x4*)ue(tn, sn, 0, 1), bp); }
        else {
#pragma unroll
            for (int j = 0; j < 8; ++j) { ap[j] = 0.f; bp[j] = 0.f; } }
        float wa[3][8], wb[3][8];
#pragma unroll
        for (int k = 0; k < 3; ++k) { const f32x4 a0 = *(const f32x4*)(cw + k * NIN + c0), a1 = *(const f32x4*)(cw + k * NIN + c0 + 4), b0 = *(const f32x4*)(cw + k * NIN + DFF + c0), b1 = *(const f32x4*)(cw + k * NIN + DFF + c0 + 4);
            wa[k][0] = a0.x; wa[k][1] = a0.y; wa[k][2] = a0.z; wa[k][3] = a0.w; wa[k][4] = a1.x; wa[k][5] = a1.y; wa[k][6] = a1.z; wa[k][7] = a1.w;
            wb[k][0] = b0.x; wb[k][1] = b0.y; wb[k][2] = b0.z; wb[k][3] = b0.w; wb[k][4] = b1.x; wb[k][5] = b1.y; wb[k][6] = b1.z; wb[k][7] = b1.w; }
        float o[8];
#pragma unroll
        for (int j = 0; j < 8; ++j) { const float a = wa[0][j] * am[j] + wa[1][j] * ac[j] + wa[2][j] * ap[j]; const float b = wb[0][j] * bm[j] + wb[1][j] * bc[j] + wb[2][j] * bp[j]; o[j] = pg8::gelu_gate(a, b); }
        u32x4 w; w.x = pk2(o[0], o[1]); w.y = pk2(o[2], o[3]); w.z = pk2(o[4], o[5]); w.w = pk2(o[6], o[7]);
        *(u32x4*)(ACT + (size_t)g * DFF + c0) = w;
    }
}

__device__ __forceinline__ void phase_K(const Ctx& F) {
    LAS float* Gf = (LAS float*)F.lds;
    { const float* mc = (const float*)(F.wsp() + WS_MODC);
      for (int i = F.tid; i < 3 * DM; i += NTHREADS) { const int mv = i >> 11, c = i & 2047; Gf[i] = mc[(mv * 6 + MC_GF) * DM + c]; } }
    __syncthreads();
    const int gw = F.vcu * NWAVES + F.wave, NGW = F.G * NWAVES;
    const bf16_t* Fb = (const bf16_t*)(F.wsp() + WS_FSLAB);
    for (int r = gw; r < TT; r += NGW) {
        const int mv = row_mv(r); const u32x2* fr = (const u32x2*)(Fb + (size_t)r * DM) + F.lane;
        f32x4 v[8]; float ss = 0.f;
        if (r >= TP) { const u32x2* sp = fr + ((size_t)TT * DM - (size_t)TP * DM) / 4;
            u32x2 q0[8], q1[8], q2[8], q3[8];
#pragma unroll
            for (int j = 0; j < 8; ++j) { q0[j] = fr[64 * j]; q1[j] = sp[64 * j]; q2[j] = sp[64 * j + (size_t)TSM * DM / 4]; q3[j] = sp[64 * j + 2 * (size_t)TSM * DM / 4]; }
#pragma unroll
            for (int j = 0; j < 8; ++j) v[j] = (bf4(q0[j]) + bf4(q1[j])) + (bf4(q2[j]) + bf4(q3[j]));
        } else { u32x2 q0[8];
#pragma unroll
            for (int j = 0; j < 8; ++j) q0[j] = fr[64 * j];
#pragma unroll
            for (int j = 0; j < 8; ++j) v[j] = bf4(q0[j]); }
#pragma unroll
        for (int j = 0; j < 8; ++j) ss += (v[j].x * v[j].x + v[j].y * v[j].y) + (v[j].z * v[j].z + v[j].w * v[j].w);
        const float rstd = rsqrtf(wave_sum(ss) * (1.0f / DM) + 1e-6f);
        f32x4* xo = (f32x4*)(F.outp() + (size_t)r * DM) + F.lane; f32x4 xv[8];
#pragma unroll
        for (int j = 0; j < 8; ++j) xv[j] = xo[64 * j];
#pragma unroll
        for (int j = 0; j < 8; ++j) { const int c = 4 * F.lane + 256 * j; const f32x4 g = *(const LAS f32x4*)(Gf + mv * DM + c); xv[j] = xv[j] + g * (v[j] * rstd); }
#pragma unroll
        for (int j = 0; j < 8; ++j) xo[64 * j] = xv[j];
    }
}

constexpr int N_PHASES = 11;
template <int LO, int HI>
__global__ void __launch_bounds__(NTHREADS, 2) hyret_fwd(Args args) {
    extern __shared__ __attribute__((aligned(16))) unsigned char lds_raw[];
    Ctx F;
    F.lds = (LAS unsigned char*)lds_raw; F.tid = threadIdx.x; F.lane = F.tid & 63; F.wave = __builtin_amdgcn_readfirstlane(F.tid >> 6);
    F.G = gridDim.x; { const int bx = blockIdx.x; F.vcu = (F.G % 8 == 0) ? (bx % 8) * (F.G / 8) + bx / 8 : bx; }
    F.in_ = args.in; F.out_ = args.out; F.ws_ = args.ws;
    volatile LAS unsigned* MISC = (volatile LAS unsigned*)(F.lds + LDS_MISC);
    if (F.tid < 64) MISC[F.tid] = 0u;
    __syncthreads();
    constexpr int lo = LO, hi = HI;
    XcdBarrier bar; bar.bar = (unsigned*)(F.wsp() + WS_CTL) + CW_BAR + args.li * XCD_BAR_WORDS; bar.x = 0; bar.st = nullptr;
    if constexpr (hi - lo > 1) bar = xcd_barrier_post((unsigned*)(F.wsp() + WS_CTL) + CW_BAR + args.li * XCD_BAR_WORDS, MISC + 8);
#define IN(k) (lo <= (k) && (k) < hi)
#define SEAM(k) do { if constexpr (IN(k) && IN((k) + 1)) xcd_barrier(bar); } while (0)

#define BODY_0  { const Ctx P = phase_ctx(F); phase_A(P); }
#define BODY_1  { const Ctx P = phase_ctx(F); phase_B(P); }
#define BODY_2  { const Ctx P = phase_ctx(F);   \
        { pg8::Gemm g; g.A0 = g.A1 = (const bf16_t*)(P.wsp() + WS_R1); g.B0 = g.B1 = (const bf16_t*)((const unsigned char*)P.outp() + OUT_WIN); g.M = TT; g.N = 3072; g.K = DM; \
          pg8::Order S; S.init(TT, 3072, DM, P.G, (int)blockIdx.x, 1); \
          pg8::EpiHyT E{(bf16_t*)(P.wsp() + WS_X1T), (bf16_t*)(P.wsp() + WS_X2T), (bf16_t*)(P.wsp() + WS_VT)}; \
          pg8::gemm_phase<pg8::EpiHyT, pg8::Order>(P.lds, g, S, E); } \
        { pg8::Gemm g; g.A0 = g.A1 = (const bf16_t*)(P.wsp() + WS_R1); g.B0 = g.B1 = (const bf16_t*)((const unsigned char*)P.outp() + OUT_WIN) + (size_t)3072 * DM; g.M = TT; g.N = NPJ; g.K = DM; \
          pg8::Order S; S.init(TT, NPJ, DM, P.G, (int)blockIdx.x, 1); \
          pg8::EpiBf16 E{(bf16_t*)(P.wsp() + WS_PROJ), NPJ, 0}; \
          pg8::gemm_phase<pg8::EpiBf16, pg8::Order>(P.lds, g, S, E); } }
#define BODY_3  { const Ctx P = phase_ctx(F); phase_D(P); }
#define BODY_4  { const Ctx P = phase_ctx(F);   \
        pg8::Gemm g; g.A0 = (const bf16_t*)(P.wsp() + WS_R1); g.A1 = (const bf16_t*)(P.wsp() + WS_R1) + (size_t)TT * DHY; g.B0 = (const bf16_t*)(P.wsp() + WS_WBRH); g.B1 = (const bf16_t*)(P.wsp() + WS_WBRR); g.M = TT; g.N = DM; g.K = DHY; \
        pg8::Order S; S.init(TT, DM, DHY, P.G, (int)blockIdx.x, 2); S.vc2 = P.vcu; \
        pg8::EpiMerge E{(bf16_t*)(P.wsp() + WS_R2), (const bf16_t*)(P.wsp() + WS_PROJ)}; \
        pg8::gemm_phase<pg8::EpiMerge, pg8::Order>(P.lds, g, S, E); \
        { const int n2 = (TT / 256) * (DM / 256) - P.G;        \
          if (n2 < 0 || n2 >= P.G) late_transposes(P, P.vcu, P.G); else if (P.vcu >= n2) late_transposes(P, P.vcu - n2, P.G - n2); } }
#define BODY_5  { const Ctx P = phase_ctx(F);   \
        pg8::Gemm g; g.A0 = g.A1 = (const bf16_t*)(P.wsp() + WS_R2); g.B0 = g.B1 = (const bf16_t*)(P.wsp() + WS_WOUT); g.M = TT; g.N = DM; g.K = DM; \
        pg8::TwoRoundOrder S; S.init(TT, DM, DM, P.G, P.vcu); \
        pg8::EpiBf16 E{(bf16_t*)(P.wsp() + WS_PROJ), DM, (size_t)TT * DM}; \
        pg8::gemm_phase<pg8::EpiBf16, pg8::TwoRoundOrder>(P.lds, g, S, E); }
#define BODY_6  { const Ctx P = phase_ctx(F); phase_G(P); }
#define BODY_7  { const Ctx P = phase_ctx(F);   \
        pg8::Gemm g; g.A0 = g.A1 = (const bf16_t*)(P.wsp() + WS_R1); g.B0 = g.B1 = (const bf16_t*)(P.wsp() + WS_WUP); g.M = TT; g.N = NIN; g.K = DM; \
        pg8::Order S; S.init(TT, NIN, DM, P.G, (int)blockIdx.x, 1); \
        pg8::EpiGate E{(bf16_t*)(P.wsp() + WS_ACT2), (bf16_t*)(P.wsp() + WS_UE), P.inp(I_FFNCONV)}; \
        pg8::gemm_phase<pg8::EpiGate, pg8::Order>(P.lds, g, S, E); }
#define BODY_8  { const Ctx P = phase_ctx(F); phase_I(P); }
#define BODY_9  { const Ctx P = phase_ctx(F);   \
        pg8::Gemm g; g.A0 = g.A1 = (const bf16_t*)(P.wsp() + WS_ACT2); g.B0 = g.B1 = (const bf16_t*)(P.wsp() + WS_WDOWN); g.M = TT; g.N = DM; g.K = DFF; \
        pg8::TwoRoundOrder S; S.init(TT, DM, DFF, P.G, P.vcu); \
        pg8::EpiBf16 E{(bf16_t*)(P.wsp() + WS_FSLAB), DM, (size_t)TT * DM}; \
        pg8::gemm_phase<pg8::EpiBf16, pg8::TwoRoundOrder>(P.lds, g, S, E); }
#define BODY_10  { const Ctx P = phase_ctx(F); phase_K(P); }
    if constexpr (IN(0)) { BODY_0 } SEAM(0);
    if constexpr (IN(1)) { BODY_1 } SEAM(1);
    if constexpr (IN(2)) { BODY_2 } SEAM(2);
    if constexpr (IN(3)) { BODY_3 } SEAM(3);
    if constexpr (IN(4)) { BODY_4 } SEAM(4);
    if constexpr (IN(5)) { BODY_5 } SEAM(5);
    if constexpr (IN(6)) { BODY_6 } SEAM(6);
    if constexpr (IN(7)) { BODY_7 } SEAM(7);
    if constexpr (IN(8)) { BODY_8 } SEAM(8);
    if constexpr (IN(9)) { BODY_9 } SEAM(9);
    if constexpr (IN(10)) { BODY_10 }
#undef IN
#undef SEAM
}

typedef void (*kern_t)(Args);
template <int PH> static kern_t phase_kernel() { return hyret_fwd<PH, PH + 1>; }
extern "C" void kernel_launch(void* const* d_in, const int* in_sizes, int n_in, void* d_out, int out_size, void* d_ws, size_t ws_size, hipStream_t stream) {
    static int grid = 0;
#if MK_N_LAUNCHES == 1
    static const kern_t kerns[1] = {hyret_fwd<0, N_PHASES>};
    constexpr int NK = 1;
#else
    static const kern_t kerns[N_PHASES] = {phase_kernel<0>(), phase_kernel<1>(), phase_kernel<2>(), phase_kernel<3>(), phase_kernel<4>(), phase_kernel<5>(),
                                           phase_kernel<6>(), phase_kernel<7>(), phase_kernel<8>(), phase_kernel<9>(), phase_kernel<10>()};
    constexpr int NK = N_PHASES;
#endif
    if (grid == 0) {
        if (n_in != 30 || ws_size < WS_END) { fprintf(stderr, "kernel_launch: need 30 inputs and >= %zu bytes of workspace; got n_in %d ws %zu\n", (size_t)WS_END, n_in, ws_size); grid = -1; return; }
        int dev = 0, cus = 0, per_cu = 0;
        if (hipGetDevice(&dev) != hipSuccess || hipDeviceGetAttribute(&cus, hipDeviceAttributeMultiprocessorCount, dev) != hipSuccess) { grid = -1; return; }
        for (int k = 0; k < NK; ++k) {
            if (hipFuncSetAttribute((const void*)kerns[k], hipFuncAttributeMaxDynamicSharedMemorySize, LDS_BYTES) != hipSuccess) { fprintf(stderr, "kernel_launch: hipFuncSetAttribute failed\n"); grid = -1; return; }
            if (hipOccupancyMaxActiveBlocksPerMultiprocessor(&per_cu, (const void*)kerns[k], NTHREADS, LDS_BYTES) != hipSuccess || per_cu < 1) { fprintf(stderr, "kernel_launch: occupancy query says %d blocks per CU for kernel %d\n", per_cu, k); }
        }
        (void)hipGetLastError();
        if (cus != 256) { fprintf(stderr, "kernel_launch: built for a 256-CU device (work decomposition), found %d CUs; nothing launched\n", cus); grid = -1; return; }
        grid = cus;
    }
    if (grid < 0) return;
    (void)hipMemsetAsync((char*)d_ws + WS_CTL, 0, CTL_ZERO_BYTES, stream);
    Args a{};
    for (int i = 0; i < 30; ++i) a.in[i] = (const GAS float*)d_in[i];
    a.out = (GAS float*)d_out; a.ws = (GAS unsigned char*)d_ws;
    for (int k = 0; k < NK; ++k) { a.ph_lo = 0; a.ph_hi = 0; a.li = 0; hipLaunchKernelGGL(kerns[k], dim3(grid), dim3(NTHREADS), LDS_BYTES, stream, a); }
}
```

```cpp
#include <hip/hip_runtime.h>
#include <cstdio>
#include <cstdint>

#ifndef MK_N_LAUNCHES
#define MK_N_LAUNCHES 1
#endif

#define LAS __attribute__((address_space(3)))
#define GAS __attribute__((address_space(1)))
typedef unsigned short bf16_t;
typedef short bf16x8 __attribute__((ext_vector_type(8)));
typedef float f32x4 __attribute__((ext_vector_type(4)));
typedef float f32x2 __attribute__((ext_vector_type(2)));
typedef float f32x16 __attribute__((ext_vector_type(16)));
typedef unsigned u32x4 __attribute__((ext_vector_type(4)));
typedef unsigned u32x2 __attribute__((ext_vector_type(2)));

constexpr int DM = 2048, TP = 8192, TSM = 2048, TT = 10240, LP = 256, LS = 1024;
constexpr int NIN = 11264, DHY = 1024, NH = 8, HD = 128, DFF = 5632;
constexpr int NPJ = 8192, PJP = 4096;
constexpr int O_Q = 0, O_K = 1024, O_V = 2048, O_G = 3072, O_GHY = 4096, O_GRET = 6144;
constexpr int NWAVES = 8, NTHREADS = 512;

constexpr size_t MiB = 1u << 20;
constexpr size_t WS_CTL = 0, CTL_ZERO_BYTES = 1 * MiB;
constexpr size_t WS_MODP = 1 * MiB;
constexpr size_t WS_MODC = 1 * MiB + 512 * 1024;
constexpr int CW_MODC = 2112;
constexpr int CW_ADA = 2048;
enum { MC_AM = 0, MC_BM, MC_GM, MC_AF, MC_BF, MC_GF };
constexpr size_t WS_R1 = 6 * MiB;
constexpr size_t WS_R2 = 46 * MiB;
constexpr size_t WS_X1T = 46 * MiB, WS_X2T = 66 * MiB, WS_VT = 276 * MiB;
constexpr size_t WS_WOUT = 86 * MiB, WS_WBRH = 94 * MiB, WS_WBRR = 98 * MiB;
constexpr size_t WS_GATE = 196 * MiB;
constexpr size_t WS_PROJ = 116 * MiB;
constexpr size_t WS_WUP = 336 * MiB, WS_WDOWN = 380 * MiB, WS_END = 402 * MiB;
constexpr size_t WS_ACT2 = 116 * MiB, WS_FSLAB = 226 * MiB, WS_UE = 292 * MiB;
constexpr size_t OUT_WIN = 0, OUT_F256 = 44 * MiB, OUT_F1024 = 48 * MiB, OUT_STATE = 80 * MiB;
constexpr int CW_BAR = 4096;

typedef __bf16 bf16v2 __attribute__((ext_vector_type(2)));
__device__ __forceinline__ unsigned pk2(float lo, float hi) { const f32x2 v = {lo, hi}; return __builtin_bit_cast(unsigned, __builtin_convertvector(v, bf16v2)); }
__device__ __forceinline__ unsigned f2bf(float f) { return pk2(f, 0.f) & 0xffffu; }
__device__ __forceinline__ float bflo(unsigned w) { return __builtin_bit_cast(float, w << 16); }
__device__ __forceinline__ float bfhi(unsigned w) { return __builtin_bit_cast(float, w & 0xffff0000u); }
__device__ __forceinline__ float bf2f(bf16_t b) { return __builtin_bit_cast(float, ((unsigned)b) << 16); }
__device__ __forceinline__ f32x4 bf4(u32x2 w) { return (f32x4){bflo(w.x), bfhi(w.x), bflo(w.y), bfhi(w.y)}; }
__device__ __forceinline__ float sigmoidf_(float x) { return 1.0f / (1.0f + __expf(-x)); }

namespace pg8 {
constexpr int BM = 256, BK = 64, HALF = 128, HTB = HALF * BK * 2, STAGE_BYTES = 8 * HTB, NXCD = 8, WGM = 8;
__host__ __device__ __forceinline__ int lds_byte(int r, int c) { const int st = (r >> 4) * 2 + (c >> 5), rr = r & 15, cc = c & 31, ob = rr * 64 + cc * 2; return st * 1024 + (ob ^ (((ob >> 9) & 1) << 5)); }
__host__ __device__ __forceinline__ void stage_rc(int b, int& R, int& C) { const int st = b / 1024, sb = b % 1024, swz = sb ^ (((sb >> 9) & 1) << 5); R = (st >> 1) * 16 + swz / 64; C = (st & 1) * 32 + (swz % 64) / 2; }
__host__ __device__ __forceinline__ int perm32(int rho) { const int n = rho >> 4, i = rho & 15; return 8 * (i >> 2) + 4 * n + (i & 3); }

struct Unit { int pm, pn, sub, kt0, nkt, part; };
struct Gemm { const bf16_t* A0; const bf16_t* A1; const bf16_t* B0; const bf16_t* B1; int M, N, K;
    __device__ __forceinline__ const char* a(int s) const { return (const char*)(s ? A1 : A0); } __device__ __forceinline__ const char* b(int s) const { return (const char*)(s ? B1 : B0); } };

struct Order {
    int nM, nN, nwg, G, c, nsub, ktu; int vc2 = -1;
    __device__ __forceinline__ void init(int M, int N, int K, int G_, int c_, int nsub_) { nM = M / BM; nN = N / BM; nwg = nM * nN; G = G_; c = c_; nsub = nsub_; ktu = K / BK; }
    __device__ __forceinline__ bool next(int i, Unit& u) const {
        const int ii = i / nsub; u.sub = i - ii * nsub; u.kt0 = 0; u.nkt = ktu; u.part = 0;
        const long L = (ii == 1 && vc2 >= 0) ? (long)G + vc2 : (long)ii * G + c; if (L >= nwg) return false;
        int wgid = (int)L; { const int q = nwg / NXCD, r = nwg % NXCD, xcd = wgid % NXCD, off = wgid / NXCD; wgid = (xcd < r ? xcd * (q + 1) : r * (q + 1) + (xcd - r) * q) + off; }
        const int nig = WGM * nN, gid = wgid / nig, fm = gid * WGM, gsz = (nM - fm) < WGM ? (nM - fm) : WGM;
        u.pm = fm + ((wgid % nig) % gsz); u.pn = (wgid % nig) / gsz; return true;
    }
};

struct TwoRoundOrder {
    int ktu, vc; bool ok;
    __device__ __forceinline__ void init(int M, int N, int K, int G, int vc_) { ktu = K / BK; vc = vc_; ok = (G == 256 && M == 10240 && N == 2048 && (ktu % 8) == 0); }
    __device__ __forceinline__ bool next(int i, Unit& u) const {
        const int x = vc >> 5, j = vc & 31; u.sub = 0;
        if (i == 0) { u.pm = 8 * (x >> 1) + (j & 7); u.pn = 4 * (x & 1) + (j >> 3); u.kt0 = 0; u.nkt = ktu; u.part = 0; return true; }
        if (i == 1) { const int q = x & 3; u.pm = 32 + (j & 7); u.pn = 4 * (x >> 2) + (j >> 3); u.kt0 = q * (ktu >> 2); u.nkt = ktu >> 2; u.part = q; return true; }
        return false;
    }
};
__device__ __forceinline__ unsigned cvt_pk_bf16(float lo, float hi) { unsigned r; asm volatile("v_cvt_pk_bf16_f32 %0, %1, %2" : "=v"(r) : "v"(lo), "v"(hi)); return r; }

struct EpiF32 {
    static constexpr bool PERM = false, SWAP = false; static constexpr int PERMA = 0;
    float* C; int ldc; size_t slab;
    __device__ __forceinline__ bool keep(const Unit&) const { return false; }
    __device__ __forceinline__ void operator()(f32x4 (&acc)[2][2][4][2], const Unit& u, int wr, int wc, int fr, int fq) const {
        const int row0 = u.pm * BM + wr * 64 + fr, col0 = u.pn * BM + wc * 32 + 4 * fq;
        float* Cp = u.part == 0 ? C : C + slab + (size_t)(u.part - 1) * 2048 * ldc - (size_t)8192 * ldc;
#pragma unroll
        for (int ai = 0; ai < 2; ++ai)
#pragma unroll
            for (int m = 0; m < 4; ++m) { float* rowp = Cp + (size_t)(row0 + ai * HALF + m * 16) * ldc + col0;
#pragma unroll
                for (int bj = 0; bj < 2; ++bj)
#pragma unroll
                    for (int n = 0; n < 2; ++n) *(f32x4*)(rowp + bj * HALF + n * 16) = acc[ai][bj][m][n]; }
    }
};
struct EpiBf16 {
    static constexpr bool PERM = true, SWAP = false; static constexpr int PERMA = 0;
    bf16_t* O; int ldc; size_t slab;
    __device__ __forceinline__ bool keep(const Unit&) const { return false; }
    __device__ __forceinline__ void operator()(f32x4 (&acc)[2][2][4][2], const Unit& u, int wr, int wc, int fr, int fq) const {
        const int row0 = u.pm * BM + wr * 64 + fr, col0 = u.pn * BM + wc * 32 + 8 * fq;
        bf16_t* Op = u.part == 0 ? O : O + slab + (size_t)(u.part - 1) * 2048 * ldc - (size_t)8192 * ldc;
#pragma unroll
        for (int ai = 0; ai < 2; ++ai)
#pragma unroll
            for (int m = 0; m < 4; ++m) { bf16_t* rowp = Op + (size_t)(row0 + ai * HALF + m * 16) * ldc + col0;
#pragma unroll
                for (int bj = 0; bj < 2; ++bj) { const f32x4 v0 = acc[ai][bj][m][0], v1 = acc[ai][bj][m][1];
                    u32x4 w; w.x = cvt_pk_bf16(v0[0], v0[1]); w.y = cvt_pk_bf16(v0[2], v0[3]); w.z = cvt_pk_bf16(v1[0], v1[1]); w.w = cvt_pk_bf16(v1[2], v1[3]);
                    *(u32x4*)(rowp + bj * HALF) = w; } }
    }
};
struct EpiProj {
    static constexpr bool PERM = true, SWAP = false; static constexpr int PERMA = 0;
    bf16_t* O; int ldc; bf16_t* G;
    __device__ __forceinline__ bool keep(const Unit&) const { return false; }
    __device__ __forceinline__ void operator()(f32x4 (&acc)[2][2][4][2], const Unit& u, int wr, int wc, int fr, int fq) const {
        const int row0 = u.pm * BM + wr * 64 + fr, col0 = u.pn * BM + wc * 32 + 8 * fq;
        const bool gate = u.pn >= O_GHY / BM;
        const int tid_ = (wr * 4 + wc) * 64 + fq * 16 + fr;
        bf16_t* gp = G + ((size_t)((u.pn - O_GHY / BM) * (TT / BM) + u.pm) * 16 * NTHREADS + tid_) * 8;
#pragma unroll
        for (int ai = 0; ai < 2; ++ai)
#pragma unroll
            for (int m = 0; m < 4; ++m) { bf16_t* rowp = O + (size_t)(row0 + ai * HALF + m * 16) * ldc + col0;
#pragma unroll
                for (int bj = 0; bj < 2; ++bj) { const f32x4 v0 = acc[ai][bj][m][0], v1 = acc[ai][bj][m][1];
                    u32x4 w; w.x = cvt_pk_bf16(v0[0], v0[1]); w.y = cvt_pk_bf16(v0[2], v0[3]); w.z = cvt_pk_bf16(v1[0], v1[1]); w.w = cvt_pk_bf16(v1[2], v1[3]);
                    bf16_t* dst = gate ? gp + (size_t)(((ai * 4 + m) * 2 + bj) * NTHREADS) * 8 : rowp + bj * HALF;
                    *(u32x4*)dst = w; } }
    }
};
__device__ __forceinline__ float dpp_ror1(float x) { return __builtin_bit_cast(float, __builtin_amdgcn_update_dpp(0, __builtin_bit_cast(int, x), 0x121, 0xF, 0xF, false)); }
__device__ __forceinline__ float dpp_ror15(float x) { return __builtin_bit_cast(float, __builtin_amdgcn_update_dpp(0, __builtin_bit_cast(int, x), 0x12F, 0xF, 0xF, false)); }
__device__ __forceinline__ f32x2 gelu_gate2(f32x2 a, f32x2 b) {
    const f32x2 k1 = {-2.3022082f, -2.3022082f}, k2 = {-0.10294324f, -0.10294324f}, one = {1.0f, 1.0f};
    const f32x2 p = a * (a * a * k2 + k1);
    const f32x2 e = {__builtin_amdgcn_exp2f(p[0]), __builtin_amdgcn_exp2f(p[1])};
    const f32x2 d = e + one;
    const f32x2 r = {__builtin_amdgcn_rcpf(d[0]), __builtin_amdgcn_rcpf(d[1])};
    return (a * b) * r;
}
__device__ __forceinline__ float gelu_gate(float a, float b) { const float u = 1.5957691216057308f * (a + 0.044715f * a * a * a); return a * __builtin_amdgcn_rcpf(1.0f + __expf(-u)) * b; }
struct EpiGate {
    static constexpr bool PERM = true, SWAP = false; static constexpr int PERMA = 1;
    bf16_t* ACT; bf16_t* UE; const float* cw;
    __device__ __forceinline__ bool keep(const Unit&) const { return false; }
    __device__ __forceinline__ void operator()(f32x4 (&acc)[2][2][4][2], const Unit& u, int wr, int wc, int fr, int fq) const {
        const int colh = u.pn * HALF + wc * 32 + 8 * fq;
#pragma unroll
        for (int ai = 0; ai < 2; ++ai) { const int strip = 2 * ai + wr;
            if (fr == 0 || fr == 15) {
#pragma unroll
                for (int h = 0; h < 2; ++h) { const int w = fr == 0 ? h : 2 + h;
                    bf16_t* ue = UE + ((size_t)((u.pm * 4 + strip) * 4 + w) * 2) * DFF + colh;
#pragma unroll
                    for (int bj = 0; bj < 2; ++bj) { const f32x4 v0 = fr == 0 ? acc[ai][bj][h][0] : acc[ai][bj][2 + h][0], v1 = fr == 0 ? acc[ai][bj][h][1] : acc[ai][bj][2 + h][1];
                        u32x4 q; q.x = cvt_pk_bf16(v0[0], v0[1]); q.y = cvt_pk_bf16(v0[2], v0[3]); q.z = cvt_pk_bf16(v1[0], v1[1]); q.w = cvt_pk_bf16(v1[2], v1[3]); *(u32x4*)(ue + (size_t)bj * DFF) = q; } } } }
        unsigned pk[2][4][2];
#pragma unroll
        for (int n = 0; n < 2; ++n) {
            f32x4 wa[3], wb[3];
#pragma unroll
            for (int k = 0; k < 3; ++k) { wa[k] = *(const f32x4*)(cw + k * (2 * DFF) + colh + 4 * n); wb[k] = *(const f32x4*)(cw + k * (2 * DFF) + DFF + colh + 4 * n); }
#pragma unroll
            for (int ai = 0; ai < 2; ++ai) {
                float o[4][4];
#pragma unroll
                for (int jp = 0; jp < 2; ++jp) {
                    f32x2 ua[4], ub[4];
#pragma unroll
                    for (int bj = 0; bj < 2; ++bj) {
                        f32x2 x[4];
#pragma unroll
                        for (int m = 0; m < 4; ++m) x[m] = (f32x2){acc[ai][bj][m][n][2 * jp], acc[ai][bj][m][n][2 * jp + 1]};
                        const f32x2 up = {dpp_ror1(x[3][0]), dpp_ror1(x[3][1])}, dn = {dpp_ror15(x[0][0]), dpp_ror15(x[0][1])};
                        const f32x4 W0 = bj == 0 ? wa[0] : wb[0], W1 = bj == 0 ? wa[1] : wb[1], W2 = bj == 0 ? wa[2] : wb[2];
                        const f32x2 w0 = {W0[2 * jp], W0[2 * jp + 1]}, w1 = {W1[2 * jp], W1[2 * jp + 1]}, w2 = {W2[2 * jp], W2[2 * jp + 1]};
                        const f32x2 c0 = w0 * up + w1 * x[0] + w2 * x[1], c1 = w0 * x[0] + w1 * x[1] + w2 * x[2], c2 = w0 * x[1] + w1 * x[2] + w2 * x[3], c3 = w0 * x[2] + w1 * x[3] + w2 * dn;
                        if (bj == 0) { ua[0] = c0; ua[1] = c1; ua[2] = c2; ua[3] = c3; } else { ub[0] = c0; ub[1] = c1; ub[2] = c2; ub[3] = c3; } }
#pragma unroll
                    for (int m = 0; m < 4; ++m) { const f32x2 gg = gelu_gate2(ua[m], ub[m]); o[m][2 * jp] = gg[0]; o[m][2 * jp + 1] = gg[1]; }
                }
#pragma unroll
                for (int m = 0; m < 4; ++m) { pk[ai][m][0] = n == 0 ? cvt_pk_bf16(o[m][0], o[m][1]) : pk[ai][m][0]; pk[ai][m][1] = n == 0 ? cvt_pk_bf16(o[m][2], o[m][3]) : pk[ai][m][1];
                    if (n == 1) { const bool edge = (m == 0 && fr == 0) || (m == 3 && fr == 15);
                        u32x4 q; q.x = pk[ai][m][0]; q.y = pk[ai][m][1]; q.z = cvt_pk_bf16(o[m][0], o[m][1]); q.w = cvt_pk_bf16(o[m][2], o[m][3]);
                        if (!edge) *(u32x4*)(ACT + (size_t)(u.pm * BM + ai * HALF + wr * 64 + 4 * fr + m) * DFF + colh) = q; } }
            }
        }
    }
};
struct EpiHyT {
    static constexpr bool PERM = false, SWAP = true; static constexpr int PERMA = 2;
    bf16_t* x1t; bf16_t* x2t; bf16_t* vt;
    __device__ __forceinline__ bool keep(const Unit&) const { return false; }
    __device__ __forceinline__ void operator()(f32x4 (&acc)[2][2][4][2], const Unit& u, int wr, int wc, int fr, int fq) const {
        const int ten = u.pn >> 2; bf16_t* pt = ten == 2 ? vt : x1t + (size_t)ten * ((size_t)DHY * TT);
        const int ch0 = (u.pn & 3) * BM + wc * 32 + fr, tok0 = u.pm * BM + wr * 64 + 8 * fq;
#pragma unroll
        for (int bj = 0; bj < 2; ++bj)
#pragma unroll
            for (int n = 0; n < 2; ++n) { bf16_t* cp = pt + (size_t)(ch0 + bj * HALF + n * 16) * TT + tok0;
#pragma unroll
                for (int ai = 0; ai < 2; ++ai)
#pragma unroll
                    for (int h = 0; h < 2; ++h) { const f32x4 v0 = acc[ai][bj][2 * h][n], v1 = acc[ai][bj][2 * h + 1][n];
                        u32x4 w; w.x = cvt_pk_bf16(v0[0], v0[1]); w.y = cvt_pk_bf16(v0[2], v0[3]); w.z = cvt_pk_bf16(v1[0], v1[1]); w.w = cvt_pk_bf16(v1[2], v1[3]);
                        *(u32x4*)(cp + ai * HALF + 32 * h) = w; } }
    }
};
struct EpiMerge {
    static constexpr bool PERM = true, SWAP = false; static constexpr int PERMA = 0;
    bf16_t* O; const bf16_t* gates;
    __device__ __forceinline__ bool keep(const Unit& u) const { return u.sub == 0; }
    static __device__ __forceinline__ f32x4 rcp4(const f32x4 v) { f32x4 r; r.x = __builtin_amdgcn_rcpf(v.x); r.y = __builtin_amdgcn_rcpf(v.y); r.z = __builtin_amdgcn_rcpf(v.z); r.w = __builtin_amdgcn_rcpf(v.w); return r; }
    template <bool CL> static __device__ __forceinline__ float en1(float x) { if (CL) x = __builtin_amdgcn_fmed3f(x, -30.f, 30.f); return __builtin_amdgcn_exp2f(x * -1.4426950408889634f); }
    template <bool CL> static __device__ __forceinline__ f32x4 enlo(const u32x4 g) { f32x4 r; r.x = en1<CL>(bflo(g.x)); r.y = en1<CL>(bfhi(g.x)); r.z = en1<CL>(bflo(g.y)); r.w = en1<CL>(bfhi(g.y)); return r; }
    template <bool CL> static __device__ __forceinline__ f32x4 enhi(const u32x4 g) { f32x4 r; r.x = en1<CL>(bflo(g.z)); r.y = en1<CL>(bfhi(g.z)); r.z = en1<CL>(bflo(g.w)); r.w = en1<CL>(bfhi(g.w)); return r; }
    __device__ __forceinline__ void operator()(f32x4 (&acc)[2][2][4][2], const Unit& u, int wr, int wc, int fr, int fq) const {
        const int row0 = u.pm * BM + wr * 64 + fr, col0 = u.pn * BM + wc * 32 + 8 * fq;
        const int tid_ = (wr * 4 + wc) * 64 + fq * 16 + fr;
        const bf16_t* gA = gates + ((size_t)(u.pn * (TT / BM) + u.pm) * 16 * NTHREADS + tid_) * 8; const bf16_t* gB = gA + (size_t)(DM / BM) * (TT / BM) * 16 * NTHREADS * 8;
        if (u.sub == 0) {
#pragma unroll
            for (int ai = 0; ai < 2; ++ai)
#pragma unroll
                for (int mp = 0; mp < 2; ++mp) { u32x4 gb[2][2], ga[2][2];
#pragma unroll
                    for (int mm = 0; mm < 2; ++mm)
#pragma unroll
                        for (int bj = 0; bj < 2; ++bj) { const size_t ko = (size_t)(((ai * 4 + 2 * mp + mm) * 2 + bj) * NTHREADS) * 8; gb[mm][bj] = *(const u32x4*)(gB + ko); ga[mm][bj] = *(const u32x4*)(gA + ko); }
#pragma unroll
                    for (int mm = 0; mm < 2; ++mm)
#pragma unroll
                        for (int bj = 0; bj < 2; ++bj) { const int m = 2 * mp + mm;
                            const f32x4 b0 = enlo<true>(gb[mm][bj]), b1 = enhi<true>(gb[mm][bj]), a0 = enlo<false>(ga[mm][bj]), a1 = enhi<false>(ga[mm][bj]);
                            acc[ai][bj][m][0] = acc[ai][bj][m][0] * ((1.0f + b0) * rcp4(1.0f + a0));
                            acc[ai][bj][m][1] = acc[ai][bj][m][1] * ((1.0f + b1) * rcp4(1.0f + a1)); } }
        } else {
#pragma unroll
            for (int ai = 0; ai < 2; ++ai) { u32x4 gb[4][2];
#pragma unroll
                for (int m = 0; m < 4; ++m)
#pragma unroll
                    for (int bj = 0; bj < 2; ++bj) gb[m][bj] = *(const u32x4*)(gB + (size_t)(((ai * 4 + m) * 2 + bj) * NTHREADS) * 8);
#pragma unroll
                for (int m = 0; m < 4; ++m) { const size_t row = (size_t)(row0 + ai * HALF + m * 16);
#pragma unroll
                    for (int bj = 0; bj < 2; ++bj) {
                        const f32x4 b0 = enlo<true>(gb[m][bj]), b1 = enhi<true>(gb[m][bj]);
                        const f32x4 v0 = acc[ai][bj][m][0] * rcp4(1.0f + b0), v1 = acc[ai][bj][m][1] * rcp4(1.0f + b1);
                        u32x4 w; w.x = cvt_pk_bf16(v0[0], v0[1]); w.y = cvt_pk_bf16(v0[2], v0[3]); w.z = cvt_pk_bf16(v1[0], v1[1]); w.w = cvt_pk_bf16(v1[2], v1[3]);
                        *(u32x4*)(O + row * DM + col0 + bj * HALF) = w; } } }
        }
    }
};

template <class Epi, class Sched>
__device__ __forceinline__ void gemm_phase(LAS unsigned char* lds, const Gemm g, const Sched& S, const Epi& E) {
    int tid = threadIdx.x; asm volatile("" : "+v"(tid));
    const int wid = __builtin_amdgcn_readfirstlane(tid >> 6), lane = tid & 63, wr = wid >> 2, wc = wid & 3, fr = lane & 15, fq = lane >> 4;
    const int K = g.K;
    unsigned voffA[2], voffB[2];
#pragma unroll
    for (int i = 0; i < 2; ++i) { int R, C; stage_rc(tid * 16 + i * 8192, R, C); const int Rb = Epi::PERM ? ((R & ~31) + perm32(R & 31)) : R;
        const int Ra = Epi::PERMA == 1 ? ((R & ~63) + 4 * (R & 15) + ((R >> 4) & 3)) : Epi::PERMA == 2 ? ((R & ~31) + 8 * ((R >> 2) & 3) + 4 * ((R >> 4) & 1) + (R & 3)) : R;
        voffA[i] = (unsigned)(Ra * K + C) * 2u; voffB[i] = (unsigned)(Rb * K + C) * 2u; }
    const size_t kstep = (size_t)(BK * 2);
    const size_t hstep = (size_t)HALF * K * 2;
    const size_t tstep = 2 * hstep;
    const unsigned ldsw = (unsigned)wid * 1024u;
    const int aoff = lds_byte(wr * 64 + fr, fq * 8), boff = lds_byte(wc * 32 + fr, fq * 8);
#define PG8_SA(b, h) (((b) * 2 + (h)) * HTB)
#define PG8_SB(b, h) ((4 + (b) * 2 + (h)) * HTB)
#define PG8_STAGE(bufoff, gbase, voff) do { _Pragma("unroll") for (int _i = 0; _i < 2; ++_i) \
        __builtin_amdgcn_global_load_lds((const unsigned*)((const char*)(gbase) + (voff)[_i]), (LAS unsigned*)(lds + (bufoff) + ldsw + _i * 8192), 16, 0, 0); } while (0)
#define PG8_LDA(dst, b, h) do { _Pragma("unroll") for (int m = 0; m < 4; ++m) _Pragma("unroll") for (int k = 0; k < 2; ++k) dst[m][k] = *(const LAS bf16x8*)(lds + PG8_SA(b, h) + aoff + m * 2048 + k * 1024); } while (0)
#define PG8_LDB(dst, b, h) do { _Pragma("unroll") for (int n = 0; n < 2; ++n) _Pragma("unroll") for (int k = 0; k < 2; ++k) dst[n][k] = *(const LAS bf16x8*)(lds + PG8_SB(b, h) + boff + n * 2048 + k * 1024); } while (0)
#define PG8_MMA(ai, bj, At, Bt) do { __builtin_amdgcn_s_setprio(1); _Pragma("unroll") for (int m = 0; m < 4; ++m) _Pragma("unroll") for (int n = 0; n < 2; ++n) _Pragma("unroll") for (int k = 0; k < 2; ++k) \
        acc[ai][bj][m][n] = Epi::SWAP ? __builtin_amdgcn_mfma_f32_16x16x32_bf16(At[m][k], Bt[n][k], acc[ai][bj][m][n], 0, 0, 0) : __builtin_amdgcn_mfma_f32_16x16x32_bf16(Bt[n][k], At[m][k], acc[ai][bj][m][n], 0, 0, 0); __builtin_amdgcn_s_setprio(0); } while (0)
#define PG8_WAIT_V(n) asm volatile("s_waitcnt vmcnt(" #n ")" ::: "memory")
#define PG8_WAIT_L(n) asm volatile("s_waitcnt lgkmcnt(" #n ")" ::: "memory")
#define PG8_BAR __builtin_amdgcn_s_barrier()
#define PG8_SCHED __builtin_amdgcn_sched_barrier(0)
    Unit cur, nxt; int ui = 0;
    if (!S.next(0, cur)) return;
    f32x4 acc[2][2][4][2];
#pragma unroll
    for (int a = 0; a < 2; ++a)
#pragma unroll
        for (int b = 0; b < 2; ++b)
#pragma unroll
            for (int m = 0; m < 4; ++m)
#pragma unroll
                for (int n = 0; n < 2; ++n) acc[a][b][m][n] = (f32x4){0.f, 0.f, 0.f, 0.f};
    bf16x8 At[4][2], B0[2][2], B1[2][2];
    const char* cA = g.a(cur.sub) + (size_t)cur.pm * tstep + (size_t)cur.kt0 * kstep; const char* cB = g.b(cur.sub) + (size_t)cur.pn * tstep + (size_t)cur.kt0 * kstep;
    PG8_STAGE(PG8_SB(0, 0), cB, voffB); PG8_STAGE(PG8_SB(0, 1), cB + hstep, voffB); PG8_STAGE(PG8_SA(0, 0), cA, voffA); PG8_STAGE(PG8_SA(0, 1), cA + hstep, voffA);
    if (wr == 1) PG8_BAR;
    PG8_WAIT_V(2); PG8_BAR;
    PG8_STAGE(PG8_SB(1, 0), cB + kstep, voffB); PG8_STAGE(PG8_SA(1, 0), cA + kstep, voffA); PG8_STAGE(PG8_SB(1, 1), cB + hstep + kstep, voffB);
    PG8_WAIT_V(6); PG8_BAR;
    for (;;) {
        const bool has_next = S.next(ui + 1, nxt);
        const char* nA = has_next ? g.a(nxt.sub) + (size_t)nxt.pm * tstep + (size_t)nxt.kt0 * kstep : cA; const char* nB = has_next ? g.b(nxt.sub) + (size_t)nxt.pn * tstep + (size_t)nxt.kt0 * kstep : cB;
        const int nt = cur.nkt;
        for (int t = 0; t < nt; t += 2) {
            const bool last = (t == nt - 2);
            const char* a1 = cA + (size_t)(t + 1) * kstep;
            const char* a2 = last ? nA : cA + (size_t)(t + 2) * kstep; const char* b2 = last ? nB : cB + (size_t)(t + 2) * kstep;
            const char* a3 = a2 + kstep; const char* b3 = b2 + kstep;
            PG8_LDB(B0, 0, 0); PG8_LDB(B1, 0, 1); PG8_SCHED; PG8_LDA(At, 0, 0); PG8_STAGE(PG8_SA(1, 1), a1 + hstep, voffA);
            PG8_WAIT_V(8); PG8_WAIT_L(0); PG8_BAR; PG8_MMA(0, 0, At, B0); PG8_MMA(0, 1, At, B1); PG8_BAR; PG8_SCHED;
            PG8_LDA(At, 0, 1); PG8_STAGE(PG8_SB(0, 0), b2, voffB); PG8_STAGE(PG8_SB(0, 1), b2 + hstep, voffB); PG8_STAGE(PG8_SA(0, 0), a2, voffA);
            PG8_WAIT_V(8); PG8_WAIT_L(0); PG8_BAR; PG8_MMA(1, 0, At, B0); PG8_MMA(1, 1, At, B1); PG8_BAR; PG8_SCHED;
            PG8_LDB(B0, 1, 0); PG8_LDB(B1, 1, 1); PG8_SCHED; PG8_LDA(At, 1, 0); PG8_STAGE(PG8_SA(0, 1), a2 + hstep, voffA);
            PG8_WAIT_V(8); PG8_WAIT_L(0); PG8_BAR; PG8_MMA(0, 0, At, B0); PG8_MMA(0, 1, At, B1); PG8_BAR; PG8_SCHED;
            PG8_LDA(At, 1, 1); PG8_STAGE(PG8_SB(1, 0), b3, voffB); PG8_STAGE(PG8_SB(1, 1), b3 + hstep, voffB); PG8_STAGE(PG8_SA(1, 0), a3, voffA);
            PG8_WAIT_V(8); PG8_WAIT_L(0); PG8_BAR; PG8_MMA(1, 0, At, B0); PG8_MMA(1, 1, At, B1); PG8_BAR; PG8_SCHED;
        }
        if (wr == 0) PG8_BAR;
        E(acc, cur, wr, wc, fr, fq);
        if (!has_next) break;
        if (!E.keep(cur)) {
#pragma unroll
            for (int a = 0; a < 2; ++a)
#pragma unroll
                for (int b = 0; b < 2; ++b)
#pragma unroll
                    for (int m = 0; m < 4; ++m)
#pragma unroll
                        for (int n = 0; n < 2; ++n) acc[a][b][m][n] = (f32x4){0.f, 0.f, 0.f, 0.f};
        }
        cur = nxt; cA = nA; cB = nB; ++ui;
        if (wr == 1) PG8_BAR;
    }
    PG8_WAIT_V(0);
    PG8_BAR;
#undef PG8_SA
#undef PG8_SB
#undef PG8_STAGE
#undef PG8_LDA
#undef PG8_LDB
#undef PG8_MMA
#undef PG8_WAIT_V
#undef PG8_WAIT_L
#undef PG8_BAR
#undef PG8_SCHED
}
}

#define XB_TMO      128
#define XB_XCNT(j)  (256  + 64 * (j))
#define XB_XSUB(j)  (1280 + 64 * (j))
#define XB_XGEN(j)  (2304 + 64 * (j))
#define XB_TOP      3328
#define XB_TOPGEN   3392
#define XCD_BAR_WORDS 3456
#define XB_SPIN_CAP (1u << 20)
__device__ __forceinline__ unsigned xb_ld(unsigned* p)              { return __hip_atomic_load(p, __ATOMIC_RELAXED, __HIP_MEMORY_SCOPE_AGENT); }
__device__ __forceinline__ unsigned xb_add(unsigned* p, unsigned v) { return __hip_atomic_fetch_add(p, v, __ATOMIC_RELAXED, __HIP_MEMORY_SCOPE_AGENT); }
__device__ __forceinline__ unsigned xb_xcc_id() { return (unsigned)__builtin_amdgcn_s_getreg((3 << 11) | 20) & 0xFu; }
#define XB_SPIN(cond, bar) do { unsigned _sp = 0; while (cond) { __builtin_amdgcn_s_sleep(1); \
    if ((++_sp & 255u) == 0u) { if (xb_ld(&(bar)[XB_TMO])) break; if (_sp > XB_SPIN_CAP) { atomicAdd(&(bar)[XB_TMO], 1u); break; } } } } while (0)
struct XcdBarrier { unsigned* bar; unsigned x; volatile LAS unsigned* st; };
__device__ __forceinline__ XcdBarrier xcd_barrier_post(unsigned* bar, volatile LAS unsigned* st) {
    XcdBarrier b; b.bar = bar; b.x = xb_xcc_id(); b.st = st;
    if (threadIdx.x == 0) (void)xb_add(&bar[XB_XCNT(b.x)], 1u);
    return b;
}
__device__ __forceinline__ void xcd_barrier_complete(unsigned* bar, unsigned x, unsigned& nloc, unsigned& nx) {
    const unsigned G = gridDim.x * gridDim.y * gridDim.z;
    unsigned sum, cnt, mine, sp = 0u;
    for (;;) {
        sum = 0u; cnt = 0u; mine = 0u;
#pragma unroll
        for (unsigned j = 0; j < 16; ++j) { const unsigned c = xb_ld(&bar[XB_XCNT(j)]); sum += c; cnt += (c > 0u) ? 1u : 0u; mine = (j == x) ? c : mine; }
        if (sum == G) break;
        __builtin_amdgcn_s_sleep(1);
        if ((++sp & 255u) == 0u) { if (xb_ld(&bar[XB_TMO])) break; if (sp > XB_SPIN_CAP) { atomicAdd(&bar[XB_TMO], 1u); break; } }
    }
    nloc = mine > 0u ? mine : 1u; nx = cnt > 0u ? cnt : 1u;
}
__device__ __forceinline__ void xcd_barrier(const XcdBarrier& b) {
    asm volatile("s_waitcnt vmcnt(0)" ::: "memory");
    __syncthreads();
    if (threadIdx.x == 0) {
        unsigned* bar = b.bar;
        __builtin_amdgcn_s_waitcnt(0);
        unsigned nloc = b.st[0], nx = b.st[1];
        if (nloc == 0u) { xcd_barrier_complete(bar, b.x, nloc, nx); b.st[0] = nloc; b.st[1] = nx; }
        const unsigned old = xb_add(&bar[XB_XSUB(b.x)], 1u);
        const unsigned gen = old / nloc;
        if (old + 1u == (gen + 1u) * nloc) {
            __builtin_amdgcn_fence(__ATOMIC_RELEASE, "agent");
            asm volatile("s_waitcnt vmcnt(0)" ::: "memory");
            const unsigned og = xb_add(&bar[XB_TOP], 1u);
            const unsigned tg = og / nx;
            if (og + 1u == (tg + 1u) * nx) xb_add(&bar[XB_TOPGEN], 1u);
            else XB_SPIN(xb_ld(&bar[XB_TOPGEN]) == tg, bar);
            __builtin_amdgcn_fence(__ATOMIC_ACQUIRE, "agent");
            xb_add(&bar[XB_XGEN(b.x)], 1u);
            asm volatile("s_waitcnt vmcnt(0)" ::: "memory");
        } else {
            XB_SPIN(xb_ld(&bar[XB_XGEN(b.x)]) == gen, bar);
            __builtin_amdgcn_fence(__ATOMIC_ACQUIRE, "agent");
            asm volatile("s_waitcnt vmcnt(0)" ::: "memory");
        }
    }
    __syncthreads();
}

constexpr int LDS_BYTES = 155648;
constexpr int LDS_MISC = 155648 - 256;
struct Args { const GAS float* in[30]; GAS float* out; GAS unsigned char* ws; int ph_lo, ph_hi, li, pad; };
struct Ctx {
    LAS unsigned char* lds; int tid, lane, wave, vcu, G;
    const GAS float* const* in_; GAS float* out_; GAS unsigned char* ws_;
    __device__ __forceinline__ const float* inp(int i) const { return (const float*)in_[i]; }
    __device__ __forceinline__ unsigned char* wsp() const { return (unsigned char*)ws_; }
    __device__ __forceinline__ float* outp() const { return (float*)out_; }
};
enum { I_XP = 0, I_XS, I_STATE, I_C, I_CCTX, I_WADA, I_BADA, I_NPREM, I_NPOSTM, I_NPREF, I_NPOSTF, I_WIN, I_HYSW, I_HYW1, I_HYB1, I_HYW2, I_HYB2, I_HYW3, I_HYB3,
       I_HYFREQ, I_HYDECAY, I_HYBIAS, I_RETLOGIT, I_RETGN, I_WBRH, I_WBRR, I_WOUT, I_WUP, I_FFNCONV, I_WDOWN };

__device__ __forceinline__ Ctx phase_ctx(const Ctx& F) { Ctx G = F; G.tid = threadIdx.x; G.lane = G.tid & 63; asm volatile("" : "+s"(G.out_), "+s"(G.ws_)); return G; }
__device__ __forceinline__ Ctx fresh(const Ctx& F) { Ctx G = F; G.tid = threadIdx.x; G.lane = G.tid & 63; asm volatile("" : "+v"(G.tid), "+v"(G.lane)); return G; }
__device__ __forceinline__ float wave_sum(float v) {
#pragma unroll
    for (int o = 1; o < 64; o <<= 1) v += __shfl_xor(v, o);
    return v;
}
__device__ __forceinline__ int row_mv(int r) { return r < TP ? 0 : 1 + ((r - TP) >> 10); }
__device__ __forceinline__ const float* x_row(const Ctx& F, int r) { return r < TP ? F.inp(I_XP) + (size_t)r * DM : F.inp(I_XS) + (size_t)(r - TP) * DM; }

template <bool GATEP = false>
__device__ __forceinline__ void transpose_item(const float* W, int K, int N, bf16_t* WT, LAS float* scr, int item, int lane) {
    const int nblk = N / 32, kb = item / nblk, nb = item % nblk, k0 = 64 * kb, n0 = 32 * nb;
    const int r0 = !GATEP ? n0 : (n0 < DFF ? 256 * (n0 >> 7) + (n0 & 127) : 256 * ((n0 - DFF) >> 7) + 128 + ((n0 - DFF) & 127));
    float v[32];
#pragma unroll
    for (int i = 0; i < 32; ++i) v[i] = W[(size_t)(k0 + 2 * i + (lane >> 5)) * N + n0 + (lane & 31)];
#pragma unroll
    for (int i = 0; i < 32; ++i) scr[(2 * i + (lane >> 5)) * 33 + (lane & 31)] = v[i];
    asm volatile("s_waitcnt lgkmcnt(0)" ::: "memory");
    const int c = lane & 7;
#pragma unroll
    for (int j = 0; j < 4; ++j) { const int n = (lane >> 3) + 8 * j; const LAS float* s = scr + (8 * c) * 33 + n;
        u32x4 o; o.x = pk2(s[0 * 33], s[1 * 33]); o.y = pk2(s[2 * 33], s[3 * 33]); o.z = pk2(s[4 * 33], s[5 * 33]); o.w = pk2(s[6 * 33], s[7 * 33]);
        *(u32x4*)(WT + (size_t)(r0 + n) * K + k0 + 8 * c) = o; }
    asm volatile("s_waitcnt lgkmcnt(0)" ::: "memory");
}

__device__ __forceinline__ void ada_item(const Ctx& F0, int it) {
    const Ctx F = fresh(F0);
    const int cs = it >> 1, kh = it & 1, c0 = 96 * cs, k0 = 1024 * kh, tid = F.tid;
    LAS float* sv = (LAS float*)F.lds;
    LAS float* red = sv + 3 * 1024;
    for (int i = tid; i < 1024; i += NTHREADS) {
        const float a = F.inp(I_CCTX)[k0 + i], b = F.inp(I_C)[k0 + i], c = F.inp(I_C)[DM + k0 + i];
        sv[i] = a * sigmoidf_(a); sv[1024 + i] = b * sigmoidf_(b); sv[2048 + i] = c * sigmoidf_(c);
    }
    __syncthreads();
    const int cl = tid % 24, rg = tid / 24;
    if (rg < 21) {
        f32x4 a0 = {0, 0, 0, 0}, a1 = {0, 0, 0, 0}, a2 = {0, 0, 0, 0};
        const float* wp = F.inp(I_WADA) + (size_t)k0 * 12288 + c0 + 4 * cl;
#pragma unroll 7
        for (int r = rg; r < 1024; r += 21) { const f32x4 w = *(const f32x4*)(wp + (size_t)r * 12288); a0 += w * sv[r]; a1 += w * sv[1024 + r]; a2 += w * sv[2048 + r]; }
        *(LAS f32x4*)(red + (rg * 3 + 0) * 96 + 4 * cl) = a0; *(LAS f32x4*)(red + (rg * 3 + 1) * 96 + 4 * cl) = a1; *(LAS f32x4*)(red + (rg * 3 + 2) * 96 + 4 * cl) = a2;
    }
    __syncthreads();
    if (tid < 288) { const int j = tid / 96, c = tid % 96; float s = 0.f;
        for (int g = 0; g < 21; ++g) s += red[(g * 3 + j) * 96 + c];
        __hip_atomic_store((float*)(F.wsp() + WS_MODP) + kh * 3 * 12288 + j * 12288 + c0 + c, s, __ATOMIC_RELAXED, __HIP_MEMORY_SCOPE_AGENT); }
    asm volatile("s_waitcnt vmcnt(0)" ::: "memory");
    __syncthreads();
    if (tid == 0) __hip_atomic_fetch_add((unsigned*)(F.wsp() + WS_CTL) + CW_ADA, 1u, __ATOMIC_RELAXED, __HIP_MEMORY_SCOPE_AGENT);
}

struct W3Frag { f32x4 w[2][8]; };
__device__ __forceinline__ void filt_w3_issue(W3Frag& f, const float* p) {
#pragma unroll
    for (int ks = 0; ks < 2; ++ks)
#pragma unroll
        for (int jj = 0; jj < 8; ++jj) f.w[ks][jj] = *(const f32x4*)(p + (size_t)(32 * ks + jj) * 4096);
}
__device__ __forceinline__ void filt_out(const W3Frag& f, const bf16x8 (&ah)[2], const bf16x8 (&al)[2], const f32x4 b3, const f32x4 dec, float* fo, int L, const float (&tn)[4]) {
#pragma unroll
    for (int e = 0; e < 4; ++e) { f32x4 acc = {0.f, 0.f, 0.f, 0.f};
#pragma unroll
        for (int ks = 0; ks < 2; ++ks) { u32x4 hi, lo;
#pragma unroll
            for (int p = 0; p < 4; ++p) { const float x0 = f.w[ks][2 * p][e], x1 = f.w[ks][2 * p + 1][e]; const unsigned h = pk2(x0, x1); hi[p] = h; lo[p] = pk2(x0 - bflo(h), x1 - bfhi(h)); }
            const bf16x8 bh = __builtin_bit_cast(bf16x8, hi), bl = __builtin_bit_cast(bf16x8, lo);
            acc = __builtin_amdgcn_mfma_f32_16x16x32_bf16(ah[ks], bh, acc, 0, 0, 0);
            acc = __builtin_amdgcn_mfma_f32_16x16x32_bf16(al[ks], bh, acc, 0, 0, 0);
            acc = __builtin_amdgcn_mfma_f32_16x16x32_bf16(ah[ks], bl, acc, 0, 0, 0); }
        f32x4 o;
#pragma unroll
        for (int i = 0; i < 4; ++i) o[i] = (acc[i] + b3[e]) * __expf(-tn[i] * fabsf(dec[e]));
        *(f32x4*)(fo + (size_t)e * L) = o; }
}
__device__ __forceinline__ void filt_item(const Ctx& F0, int v, int ch, int cq) {
    const Ctx F = fresh(F0);
    const int L = v ? LS : LP, t0 = 16 * ch, tid = F.tid, lane = F.lane, wave = F.wave;
    LAS float* zf = (LAS float*)F.lds;
    LAS float* h1 = zf + 16 * 36;
    LAS bf16_t* hh = (LAS bf16_t*)(h1 + 16 * 64);
    LAS float* w1s = h1 + 16 * 64 + 16 * 72;
    LAS float* w2s = w1s + 33 * 64;
    const int tt = tid >> 6, j = tid & 63, n = lane & 15, g = lane >> 4;
    const int col0 = 1024 * cq + 128 * wave + 4 * n;
    const f32x4 w2a = ((const f32x4*)F.inp(I_HYW2))[tid], w2b = ((const f32x4*)F.inp(I_HYW2))[tid + NTHREADS];
    const f32x4 w1a = ((const f32x4*)F.inp(I_HYW1))[tid]; f32x4 w1b = {0.f, 0.f, 0.f, 0.f};
    if (tid < 33 * 16 - NTHREADS) w1b = ((const f32x4*)F.inp(I_HYW1))[tid + NTHREADS];
    const float b1 = F.inp(I_HYB1)[j], fr1 = F.inp(I_HYFREQ)[j], b2 = F.inp(I_HYB2)[j], fr2 = F.inp(I_HYFREQ)[64 + j];
    const f32x4 b3a = *(const f32x4*)(F.inp(I_HYB3) + col0), b3b = *(const f32x4*)(F.inp(I_HYB3) + col0 + 64);
    const f32x4 dca = *(const f32x4*)(F.inp(I_HYDECAY) + col0), dcb = *(const f32x4*)(F.inp(I_HYDECAY) + col0 + 64);
    const float* w3p = F.inp(I_HYW3) + (size_t)(8 * g) * 4096 + col0;
    W3Frag fa; filt_w3_issue(fa, w3p);
    for (int e = tid; e < 16 * 33; e += NTHREADS) { const int te = e / 33, i = e % 33; const float nn = (float)(t0 + te); const float tn = nn / (float)L; const float w = 6.283185307179586f * nn / (float)L;
        float z;
        if (i == 0) z = tn; else { const int fi = (i - 1) & 15; const float f = 1e-4f + (float)fi * ((15.0f - 1e-4f) / 15.0f); z = (i <= 16) ? __cosf(w * f) : __sinf(w * f); }
        zf[te * 36 + i] = z; }
    *(LAS f32x4*)(w2s + 4 * tid) = w2a; *(LAS f32x4*)(w2s + 4 * (tid + NTHREADS)) = w2b;
    *(LAS f32x4*)(w1s + 4 * tid) = w1a; if (tid < 33 * 16 - NTHREADS) *(LAS f32x4*)(w1s + 4 * (tid + NTHREADS)) = w1b;
    __syncthreads();
    { float a0 = b1, a1 = b1;
#pragma unroll
      for (int i = 0; i < 33; ++i) { const float w = w1s[i * 64 + j]; a0 += zf[tt * 36 + i] * w; a1 += zf[(tt + 8) * 36 + i] * w; }
      h1[tt * 64 + j] = __sinf(fr1 * a0); h1[(tt + 8) * 64 + j] = __sinf(fr1 * a1); }
    W3Frag fb; filt_w3_issue(fb, w3p + 64);
    __syncthreads();
    { float a0 = b2, a1 = b2;
#pragma unroll
      for (int i = 0; i < 64; i += 4) { const f32x4 x = *(const LAS f32x4*)(h1 + tt * 64 + i), y = *(const LAS f32x4*)(h1 + (tt + 8) * 64 + i);
#pragma unroll
          for (int k = 0; k < 4; ++k) { const float w = w2s[(i + k) * 64 + j]; a0 += x[k] * w; a1 += y[k] * w; } }
      const float s0 = __sinf(fr2 * a0), s1 = __sinf(fr2 * a1);
      const unsigned hp = pk2(s0, s1); const unsigned lp = pk2(s0 - bflo(hp), s1 - bfhi(hp));
      hh[tt * 72 + j] = (bf16_t)(hp & 0xffffu); hh[(tt + 8) * 72 + j] = (bf16_t)(hp >> 16);
      hh[16 * 72 + tt * 72 + j] = (bf16_t)(lp & 0xffffu); hh[16 * 72 + (tt + 8) * 72 + j] = (bf16_t)(lp >> 16); }
    __syncthreads();
    { bf16x8 ah[2], al[2];
#pragma unroll
      for (int ks = 0; ks < 2; ++ks) { ah[ks] = *(const LAS bf16x8*)(hh + n * 72 + 32 * ks + 8 * g); al[ks] = *(const LAS bf16x8*)(hh + 16 * 72 + n * 72 + 32 * ks + 8 * g); }
      float tn[4];
#pragma unroll
      for (int i = 0; i < 4; ++i) tn[i] = (float)(t0 + 4 * g + i) / (float)L;
      float* fo = (float*)((unsigned char*)F.outp() + (v ? OUT_F1024 : OUT_F256)) + (size_t)col0 * L + t0 + 4 * g;
      filt_out(fa, ah, al, b3a, dca, fo, L, tn);
      filt_out(fb, ah, al, b3b, dcb, fo + (size_t)64 * L, L, tn); }
    __syncthreads();
}

__device__ __forceinline__ void phase_A(const Ctx& F) {
    if ((blockIdx.x & 1) == 0) { for (int it = F.vcu; it < 256; it += F.G) ada_item(F, it); }
    for (int it = F.vcu; it < 320; it += F.G) { const int ch = it >> 2, cq = it & 3; filt_item(F, ch >= 16, ch < 16 ? ch : ch - 16, cq); }
    if ((blockIdx.x & 1) != 0) { for (int it = F.vcu; it < 256; it += F.G) ada_item(F, it); }
    LAS float* scr = (LAS float*)(F.lds + F.wave * 16384);
    const int gw = F.vcu * NWAVES + F.wave, NGW = F.G * NWAVES;
    constexpr int I_IN = (DM / 64) * (NIN / 32), I_OUT = (DM / 64) * (DM / 32), I_BR = (DHY / 64) * (DM / 32);
    constexpr int NITEMS = I_IN + I_OUT + 2 * I_BR;
#pragma unroll 1
    for (int it = gw; it < NITEMS; it += NGW) {
        int r = it;
        if (r < I_IN) { transpose_item(F.inp(I_WIN), DM, NIN, (bf16_t*)((unsigned char*)F.outp() + OUT_WIN), scr, r, F.lane); continue; } r -= I_IN;
        if (r < I_OUT) { transpose_item(F.inp(I_WOUT), DM, DM, (bf16_t*)(F.wsp() + WS_WOUT), scr, r, F.lane); continue; } r -= I_OUT;
        if (r < I_BR) { transpose_item(F.inp(I_WBRH), DHY, DM, (bf16_t*)(F.wsp() + WS_WBRH), scr, r, F.lane); continue; } r -= I_BR;
        transpose_item(F.inp(I_WBRR), DHY, DM, (bf16_t*)(F.wsp() + WS_WBRR), scr, r, F.lane);
    }
    {
        if (F.tid == 0) { unsigned* cw_ = (unsigned*)(F.wsp() + WS_CTL) + CW_ADA; unsigned sp = 0;
            while (__hip_atomic_load(cw_, __ATOMIC_RELAXED, __HIP_MEMORY_SCOPE_AGENT) < 256u && ++sp < (1u << 22)) __builtin_amdgcn_s_sleep(2);
            __builtin_amdgcn_fence(__ATOMIC_ACQUIRE, "agent"); asm volatile("s_waitcnt vmcnt(0)" ::: "memory"); }
        __syncthreads();
        float* mc = (float*)(F.wsp() + WS_MODC);
        for (int e = F.vcu * NTHREADS + F.tid; e < 3 * 6 * DM; e += F.G * NTHREADS) { const int mv = e / (6 * DM), kind = (e / DM) % 6, c = e % DM; float v;
            const float* mp = (const float*)(F.wsp() + WS_MODP); const float* ba = F.inp(I_BADA);
            auto mod = [&](int idx) { return __hip_atomic_load(mp + mv * 12288 + idx, __ATOMIC_RELAXED, __HIP_MEMORY_SCOPE_AGENT) + __hip_atomic_load(mp + 3 * 12288 + mv * 12288 + idx, __ATOMIC_RELAXED, __HIP_MEMORY_SCOPE_AGENT) + ba[idx]; };
            if (kind == MC_AM) v = F.inp(I_NPREM)[c] * (1.0f + mod(DM + c)); else if (kind == MC_BM) v = mod(c); else if (kind == MC_GM) v = mod(2 * DM + c) * F.inp(I_NPOSTM)[c];
            else if (kind == MC_AF) v = F.inp(I_NPREF)[c] * (1.0f + mod(4 * DM + c)); else if (kind == MC_BF) v = mod(3 * DM + c); else v = mod(5 * DM + c) * F.inp(I_NPOSTF)[c];
            __hip_atomic_store(mc + e, v, __ATOMIC_RELAXED, __HIP_MEMORY_SCOPE_AGENT); }
        asm volatile("s_waitcnt vmcnt(0)" ::: "memory");
        __syncthreads();
        if (F.tid == 0) __hip_atomic_fetch_add((unsigned*)(F.wsp() + WS_CTL) + CW_MODC, 1u, __ATOMIC_RELAXED, __HIP_MEMORY_SCOPE_AGENT);
    }
}
__device__ __forceinline__ void late_transposes(const Ctx& F, int bi, int nb) {
    LAS float* scr = (LAS float*)(F.lds + F.wave * 16384);
    const int gw = bi * NWAVES + F.wave, NGW = nb * NWAVES;
    constexpr int I_UP = (DM / 64) * (NIN / 32), I_DN = (DFF / 64) * (DM / 32);
#pragma unroll 1
    for (int it = gw; it < I_UP + I_DN; it += NGW) {
        if (it < I_UP) transpose_item<true>(F.inp(I_WUP), DM, NIN, (bf16_t*)(F.wsp() + WS_WUP), scr, it, F.lane);
        else transpose_item(F.inp(I_WDOWN), DFF, DM, (bf16_t*)(F.wsp() + WS_WDOWN), scr, it - I_UP, F.lane);
    }
}

__device__ __forceinline__ void phase_B(const Ctx& F) {
    LAS float* Am = (LAS float*)F.lds;
    LAS float* Bm = Am + 3 * DM;
    if (F.tid == 0) { unsigned* cw_ = (unsigned*)(F.wsp() + WS_CTL) + CW_MODC; unsigned sp = 0;
        while (__hip_atomic_load(cw_, __ATOMIC_RELAXED, __HIP_MEMORY_SCOPE_AGENT) < (unsigned)F.G && ++sp < (1u << 22)) __builtin_amdgcn_s_sleep(2);
        __builtin_amdgcn_fence(__ATOMIC_ACQUIRE, "agent"); asm volatile("s_waitcnt vmcnt(0)" ::: "memory"); }
    __syncthreads();
    { const float* mc = (const float*)(F.wsp() + WS_MODC);
      for (int i = 4 * F.tid; i < 3 * DM; i += 4 * NTHREADS) { const int mv = i >> 11, c = i & 2047; *(LAS f32x4*)(Am + i) = *(const f32x4*)(mc + (mv * 6 + MC_AM) * DM + c); *(LAS f32x4*)(Bm + i) = *(const f32x4*)(mc + (mv * 6 + MC_BM) * DM + c); } }
    __syncthreads();
    const int gw = F.vcu * NWAVES + F.wave, NGW = F.G * NWAVES;
    bf16_t* H = (bf16_t*)(F.wsp() + WS_R1);
    for (int r = gw; r < TT; r += NGW) {
        const int mv = row_mv(r); const f32x4* xr = (const f32x4*)x_row(F, r) + F.lane;
        f32x4 v[8]; float ss = 0.f;
#pragma unroll
        for (int j = 0; j < 8; ++j) { v[j] = xr[64 * j]; ss += (v[j].x * v[j].x + v[j].y * v[j].y) + (v[j].z * v[j].z + v[j].w * v[j].w); }
        const float rstd = rsqrtf(wave_sum(ss) * (1.0f / DM) + 1e-6f);
        u32x2* o = (u32x2*)(H + (size_t)r * DM) + F.lane;
#pragma unroll
        for (int j = 0; j < 8; ++j) { const int c = 4 * F.lane + 256 * j; const f32x4 a = *(const LAS f32x4*)(Am + mv * DM + c), b = *(const LAS f32x4*)(Bm + mv * DM + c);
            const f32x4 h = v[j] * rstd * a + b; u32x2 w; w.x = pk2(h.x, h.y); w.y = pk2(h.z, h.w); o[64 * j] = w; }
    }
    __syncthreads();
}

__device__ __forceinline__ void unpack8(const u32x4 a, float (&x)[8]) { x[0] = bflo(a.x); x[1] = bfhi(a.x); x[2] = bflo(a.y); x[3] = bfhi(a.y); x[4] = bflo(a.z); x[5] = bfhi(a.z); x[6] = bflo(a.w); x[7] = bfhi(a.w); }
constexpr int RT_BYTES = 128 * 256;
__device__ __forceinline__ unsigned off_b(unsigned row, unsigned ch) { return 256u * row + 16u * (ch ^ (((row & 3u) << 2) | ((row >> 2) & 3u))); }
__device__ __forceinline__ bf16x8 frag_row(const LAS unsigned char* tile, int rowbase, int lane, int s) { return *(const LAS bf16x8*)(tile + off_b((unsigned)(rowbase + (lane & 31)), (unsigned)(2 * s + (lane >> 5)))); }
typedef short s16x4 __attribute__((ext_vector_type(4)));
template <bool PERM>
__device__ __forceinline__ bf16x8 frag_tr(const LAS unsigned char* tile, int r0, int c, int lane) {
    const unsigned h = lane >> 5, blk = (lane >> 4) & 1, q = (lane & 15) >> 2, p = lane & 3;
    s16x4 v[2];
#pragma unroll
    for (int tp = 0; tp < 2; ++tp) { const unsigned row = (unsigned)r0 + (PERM ? 8u * tp + 4u * h : 8u * h + 4u * tp) + q;
        v[tp] = __builtin_amdgcn_ds_read_tr16_b64_v4i16((LAS s16x4*)(tile + off_b(row, 4u * c + 2u * blk + (p >> 1)) + 8u * (p & 1))); }
    bf16x8 r; r[0] = v[0][0]; r[1] = v[0][1]; r[2] = v[0][2]; r[3] = v[0][3]; r[4] = v[1][0]; r[5] = v[1][1]; r[6] = v[1][2]; r[7] = v[1][3]; return r;
}
struct RowPref { u32x4 lo[2], hi[2]; };
__device__ __forceinline__ void rows_issue(RowPref& p, const bf16_t* src, int tid) {
#pragma unroll
    for (int k = 0; k < 2; ++k) { const int task = tid + NTHREADS * k, r = task >> 3, ch = task & 7; p.lo[k] = *(const u32x4*)(src + (size_t)r * PJP + 8 * ch); p.hi[k] = *(const u32x4*)(src + (size_t)r * PJP + 64 + 8 * ch); }
}
template <class RW>
__device__ __forceinline__ void rows_store(const RowPref& p, LAS unsigned char* tile, int tid, bool rope, int t0, float scale, const float (&inv8)[8], RW rw) {
#pragma unroll
    for (int k = 0; k < 2; ++k) { const int task = tid + NTHREADS * k, r = task >> 3, ch = task & 7; const float sc = scale * rw(r);
        float x1[8], x2[8], o1[8], o2[8]; unpack8(p.lo[k], x1); unpack8(p.hi[k], x2);
        if (rope) { const int t = t0 + r; const float pos = (float)(ch < 4 ? (t >> 6) : (t & 63));
#pragma unroll
            for (int j = 0; j < 8; ++j) { const float rev = pos * inv8[j]; const float c = __builtin_amdgcn_cosf(rev) * sc, sn = __builtin_amdgcn_sinf(rev) * sc; o1[j] = x1[j] * c - x2[j] * sn; o2[j] = x2[j] * c + x1[j] * sn; }
        } else {
#pragma unroll
            for (int j = 0; j < 8; ++j) { o1[j] = x1[j] * sc; o2[j] = x2[j] * sc; }
        }
        u32x4 w1, w2; w1.x = pk2(o1[0], o1[1]); w1.y = pk2(o1[2], o1[3]); w1.z = pk2(o1[4], o1[5]); w1.w = pk2(o1[6], o1[7]);
        w2.x = pk2(o2[0], o2[1]); w2.y = pk2(o2[2], o2[3]); w2.z = pk2(o2[4], o2[5]); w2.w = pk2(o2[6], o2[7]);
        *(LAS u32x4*)(tile + off_b(r, ch)) = w1; *(LAS u32x4*)(tile + off_b(r, ch + 8)) = w2; }
}
struct One { __device__ __forceinline__ float operator()(int) const { return 1.0f; } };

struct RetPref { RowPref q, k, v; };
__device__ __forceinline__ void ret_issue(RetPref& p, const Ctx& F, int bg, int h, int qt) {
    const bool smp = bg >= 32; const int rowb = smp ? TP + (bg - 32) * LS : bg * LP; const bf16_t* proj = (const bf16_t*)(F.wsp() + WS_PROJ);
    rows_issue(p.q, proj + (size_t)(rowb + qt * 128) * PJP + O_Q + h * HD, F.tid); rows_issue(p.k, proj + (size_t)rowb * PJP + O_K + h * HD, F.tid); rows_issue(p.v, proj + (size_t)rowb * PJP + O_V + h * HD, F.tid);
}
__device__ __forceinline__ void ret_item(const Ctx& F0, RetPref& pf, int bg, int h, int qt, bool has_next, int nbg, int nh, int nqt) {
    const Ctx F = fresh(F0);
    const bool smp = bg >= 32; const int L = smp ? LS : LP; const int rowb = smp ? TP + (bg - 32) * LS : bg * LP;
    const bf16_t* proj = (const bf16_t*)(F.wsp() + WS_PROJ);
    LAS unsigned char* Qs = F.lds; LAS unsigned char* Ks = Qs + RT_BYTES; LAS unsigned char* Vs = Ks + RT_BYTES;
    const int wm = F.wave >> 1, wn = F.wave & 1, tid = F.tid; int lane = F.lane;
    const float gf = sigmoidf_(F.inp(I_RETLOGIT)[h]), gb = sigmoidf_(F.inp(I_RETLOGIT)[NH + h]); const float lgf = __log2f(gf), lgb = __log2f(gb);
    const float kscale = 0.08838834764831845f;
    float inv8[8];
#pragma unroll
    for (int j = 0; j < 8; ++j) inv8[j] = exp2f(-(float)((8 * (tid & 7) + j) & 31) * 0.41524101186092029f) * 0.15915494309189535f;
    const bf16_t* kbase = proj + (size_t)rowb * PJP + O_K + h * HD; const bf16_t* vbase = proj + (size_t)rowb * PJP + O_V + h * HD;
    RowPref& kp = pf.k; RowPref& vp = pf.v;
    rows_store(pf.q, Qs, tid, smp, qt * 128, 1.0f, inv8, One());
    f32x16 oacc[4];
#pragma unroll
    for (int c = 0; c < 4; ++c) oacc[c] = (f32x16){};
    const int nkb = L / 128;
#pragma unroll 1
    for (int kb = 0; kb < nkb; ++kb) {
        rows_store(kp, Ks, tid, smp, kb * 128, kscale, inv8, One());
        rows_store(vp, Vs, tid, false, 0, 1.0f, inv8, One());
        __syncthreads();
        if (kb + 1 < nkb) { rows_issue(kp, kbase + (size_t)(kb + 1) * 128 * PJP, tid); rows_issue(vp, vbase + (size_t)(kb + 1) * 128 * PJP, tid); }
        asm volatile("" : "+v"(lane));
#pragma unroll
        for (int st = 0; st < 2; ++st) {
            const int s0 = 64 * wn + 32 * st;
            f32x16 x = (f32x16){};
#pragma unroll
            for (int k = 0; k < 8; ++k) x = __builtin_amdgcn_mfma_f32_32x32x16_bf16(frag_row(Ks, s0, lane, k), frag_row(Qs, 32 * wm, lane, k), x, 0, 0, 0);
            const int d0 = (qt * 128 + 32 * wm + (lane & 31)) - (kb * 128 + s0 + 4 * (lane >> 5));
            unsigned pk[8];
            const int T0 = qt * 128 + 32 * wm, S0 = kb * 128 + s0;
            if (T0 == S0) {
#pragma unroll
                for (int i = 0; i < 16; i += 2) { float v[2];
#pragma unroll
                    for (int e = 0; e < 2; ++e) { const int diff = d0 - (((i + e) & 3) + 8 * ((i + e) >> 2));
                        const float d = diff > 0 ? __builtin_amdgcn_exp2f(lgf * (float)diff) : (diff < 0 ? __builtin_amdgcn_exp2f(lgb * (float)(-diff)) : 2.0f); v[e] = x[i + e] * d; }
                    pk[i >> 1] = pk2(v[0], v[1]); }
            } else {
                const bool pos = T0 > S0;
                const float E = __builtin_amdgcn_exp2f(pos ? lgf * (float)d0 : lgb * (float)(-d0)), r1 = __builtin_amdgcn_exp2f(pos ? -lgf : lgb);
                const float r2 = r1 * r1, r3 = r2 * r1, r4 = r2 * r2, r8 = r4 * r4, r16 = r8 * r8;
                const float Eb[4] = {E, E * r8, E * r16, E * (r16 * r8)};
#pragma unroll
                for (int i = 0; i < 16; i += 4) { const float e0 = Eb[i >> 2];
                    pk[i >> 1] = pk2(x[i] * e0, x[i + 1] * (e0 * r1)); pk[(i >> 1) + 1] = pk2(x[i + 2] * (e0 * r2), x[i + 3] * (e0 * r3)); }
            }
#pragma unroll
            for (int ks2 = 0; ks2 < 2; ++ks2) {
                bf16x8 a; { u32x4 w; w.x = pk[4 * ks2]; w.y = pk[4 * ks2 + 1]; w.z = pk[4 * ks2 + 2]; w.w = pk[4 * ks2 + 3]; a = __builtin_bit_cast(bf16x8, w); }
#pragma unroll
                for (int c = 0; c < 4; ++c) oacc[c] = __builtin_amdgcn_mfma_f32_32x32x16_bf16(a, frag_tr<true>(Vs, s0 + 16 * ks2, c, lane), oacc[c], 0, 0, 0);
            }
        }
        __syncthreads();
    }
    if (smp) {
#pragma unroll 1
        for (int dir = 0; dir < 2; ++dir) {
            const float* st = F.inp(I_STATE) + ((size_t)((bg - 32) * 2 + dir) * NH + h) * HD * HD;
#pragma unroll
            for (int k = 0; k < 4; ++k) { const int e = tid + NTHREADS * k, r = e >> 4, ch = e & 15;
                const f32x4 a = *(const f32x4*)(st + r * HD + 8 * ch), b = *(const f32x4*)(st + r * HD + 8 * ch + 4);
                u32x4 w; w.x = pk2(a.x, a.y); w.y = pk2(a.z, a.w); w.z = pk2(b.x, b.y); w.w = pk2(b.z, b.w); *(LAS u32x4*)(Vs + off_b(r, ch)) = w;
                const int t = qt * 128 + r; const float sc = dir == 0 ? exp2f(lgf * (float)(t + 1)) : exp2f(lgb * (float)(L - t));
                const u32x4 q = *(const LAS u32x4*)(Qs + off_b(r, ch)); u32x4 z;
                z.x = pk2(bflo(q.x) * sc, bfhi(q.x) * sc); z.y = pk2(bflo(q.y) * sc, bfhi(q.y) * sc); z.z = pk2(bflo(q.z) * sc, bfhi(q.z) * sc); z.w = pk2(bflo(q.w) * sc, bfhi(q.w) * sc);
                *(LAS u32x4*)(Ks + off_b(r, ch)) = z; }
            __syncthreads();
#pragma unroll
            for (int ks = 0; ks < 4; ++ks) { const int kk = 4 * wn + ks; const bf16x8 a = frag_row(Ks, 32 * wm, lane, kk);
#pragma unroll
                for (int c = 0; c < 4; ++c) oacc[c] = __builtin_amdgcn_mfma_f32_32x32x16_bf16(a, frag_tr<false>(Vs, 16 * kk, c, lane), oacc[c], 0, 0, 0); }
            __syncthreads();
        }
    }
    { const int r = tid >> 2, qd = tid & 3;
      const size_t row = (size_t)(rowb + qt * 128 + r); const bf16_t* gp = proj + row * PJP + O_G + h * HD + 32 * qd; const float* gnp = F.inp(I_RETGN) + h * HD + 32 * qd;
      u32x4 gq[4]; f32x4 gn[8];
#pragma unroll
      for (int j = 0; j < 4; ++j) gq[j] = *(const u32x4*)(gp + 8 * j);
#pragma unroll
      for (int j = 0; j < 8; ++j) gn[j] = *(const f32x4*)(gnp + 4 * j);
      if (has_next) ret_issue(pf, F, nbg, nh, nqt);
      LAS float* Os = (LAS float*)F.lds + wn * (128 * 132);
      { LAS float* op = Os + (32 * wm + 4 * (lane >> 5)) * 132 + (lane & 31);
#pragma unroll
        for (int c = 0; c < 4; ++c)
#pragma unroll
            for (int i = 0; i < 16; ++i) op[((i & 3) + 8 * (i >> 2)) * 132 + 32 * c] = oacc[c][i]; }
      __syncthreads();
      const LAS float* o0 = (const LAS float*)F.lds + r * 132 + 32 * qd; float v[32]; float s = 0.f;
#pragma unroll
      for (int j = 0; j < 8; ++j) { const f32x4 x = *(const LAS f32x4*)(o0 + 4 * j) + *(const LAS f32x4*)(o0 + 128 * 132 + 4 * j); v[4 * j] = x.x; v[4 * j + 1] = x.y; v[4 * j + 2] = x.z; v[4 * j + 3] = x.w; s += (x.x + x.y) + (x.z + x.w); }
      s += __shfl_xor(s, 1); s += __shfl_xor(s, 2); const float mu = s * (1.0f / 128.0f); float q = 0.f;
#pragma unroll
      for (int j = 0; j < 32; ++j) { v[j] -= mu; q += v[j] * v[j]; }
      q += __shfl_xor(q, 1); q += __shfl_xor(q, 2); const float rstd = rsqrtf(q * (1.0f / 128.0f) + 1e-5f);
      bf16_t* yo = (bf16_t*)(F.wsp() + WS_R1) + (size_t)TT * DHY + row * DHY + h * HD + 32 * qd;
#pragma unroll
      for (int j = 0; j < 4; ++j) { float gg[8]; unpack8(gq[j], gg); const float gw[8] = {gn[2 * j].x, gn[2 * j].y, gn[2 * j].z, gn[2 * j].w, gn[2 * j + 1].x, gn[2 * j + 1].y, gn[2 * j + 1].z, gn[2 * j + 1].w}; float o[8];
#pragma unroll
          for (int e = 0; e < 8; ++e) { const float gv = gg[e]; o[e] = v[8 * j + e] * rstd * gw[e] * (gv * __builtin_amdgcn_rcpf(1.0f + __expf(-gv))); }
          u32x4 w; w.x = pk2(o[0], o[1]); w.y = pk2(o[2], o[3]); w.z = pk2(o[4], o[5]); w.w = pk2(o[6], o[7]); *(u32x4*)(yo + 8 * j) = w; } }
    __syncthreads();
}
__device__ __forceinline__ void state_item(const Ctx& F0, int b, int h) {
    const Ctx F = fresh(F0);
    const bf16_t* proj = (const bf16_t*)(F.wsp() + WS_PROJ); const int rowb = b * LP;
    LAS unsigned char* Kf = F.lds; LAS unsigned char* Kb = Kf + RT_BYTES; LAS unsigned char* Vs = Kb + RT_BYTES;
    const int wm = F.wave >> 1, wn = F.wave & 1, lane = F.lane, tid = F.tid;
    const float gf = sigmoidf_(F.inp(I_RETLOGIT)[h]), gb = sigmoidf_(F.inp(I_RETLOGIT)[NH + h]); const float lgf = __log2f(gf), lgb = __log2f(gb);
    const float kscale = 0.08838834764831845f;
    float inv8[8];
#pragma unroll
    for (int j = 0; j < 8; ++j) inv8[j] = 0.f;
    f32x16 af[2], ab[2]; af[0] = (f32x16){}; af[1] = (f32x16){}; ab[0] = (f32x16){}; ab[1] = (f32x16){};
    const bf16_t* kbase = proj + (size_t)rowb * PJP + O_K + h * HD; const bf16_t* vbase = proj + (size_t)rowb * PJP + O_V + h * HD;
    RowPref kp, vp; rows_issue(kp, kbase, tid); rows_issue(vp, vbase, tid);
#pragma unroll 1
    for (int kb = 0; kb < LP / 128; ++kb) {
        rows_store(kp, Kf, tid, false, 0, kscale, inv8, [=](int r) { return exp2f(lgf * (float)(LP - 1 - (kb * 128 + r))); });
        rows_store(kp, Kb, tid, false, 0, kscale, inv8, [=](int r) { return exp2f(lgb * (float)(kb * 128 + r)); });
        rows_store(vp, Vs, tid, false, 0, 1.0f, inv8, One());
        __syncthreads();
        if (kb + 1 < LP / 128) { rows_issue(kp, kbase + (size_t)(kb + 1) * 128 * PJP, tid); rows_issue(vp, vbase + (size_t)(kb + 1) * 128 * PJP, tid); }
#pragma unroll 2
        for (int ks = 0; ks < 8; ++ks) {
            const bf16x8 a_f = frag_tr<false>(Kf, 16 * ks, wm, lane), a_b = frag_tr<false>(Kb, 16 * ks, wm, lane);
#pragma unroll
            for (int nt = 0; nt < 2; ++nt) { const bf16x8 bv = frag_tr<false>(Vs, 16 * ks, 2 * wn + nt, lane);
                af[nt] = __builtin_amdgcn_mfma_f32_32x32x16_bf16(a_f, bv, af[nt], 0, 0, 0); ab[nt] = __builtin_amdgcn_mfma_f32_32x32x16_bf16(a_b, bv, ab[nt], 0, 0, 0); }
        }
        __syncthreads();
    }
    float* so = (float*)((unsigned char*)F.outp() + OUT_STATE) + ((size_t)(b * 2 + 0) * NH + h) * HD * HD;
    float* sb = (float*)((unsigned char*)F.outp() + OUT_STATE) + ((size_t)(b * 2 + 1) * NH + h) * HD * HD;
    { const int o0 = (32 * wm + 4 * (lane >> 5)) * HD + 64 * wn + (lane & 31);
#pragma unroll
      for (int nt = 0; nt < 2; ++nt)
#pragma unroll
        for (int i = 0; i < 16; ++i) { so[o0 + ((i & 3) + 8 * (i >> 2)) * HD + 32 * nt] = af[nt][i]; sb[o0 + ((i & 3) + 8 * (i >> 2)) * HD + 32 * nt] = ab[nt][i]; } }
}

template <bool SMP> struct HyCfg {
    static constexpr int L = SMP ? LS : LP, CP = SMP ? 4160 : 1088  , PU = SMP ? 144 : 272  , NROW = SMP ? 17 : 32,
                         NCHK = SMP ? 16 : 32  , NTAP = 2 * L + 16, NK = (NTAP + NTHREADS - 1) / NTHREADS;
    static constexpr int OFF_U = 16 * CP, BUF = NROW * PU * 2, OFF_RED = OFF_U + 3 * BUF;
};
template <bool SMP>
__device__ __forceinline__ void hy_conv(f32x4 (&acc)[2][2], const LAS unsigned char* ft, const LAS bf16_t* Ub, int wave, int lane) {
    typedef HyCfg<SMP> C;
    const int row = lane & 15, g = lane >> 4;
    const LAS unsigned char* abase = ft + 16 + (7 - (row & 7)) * C::CP + (C::L - 8 - 8 * (row >> 3) + 8 * g) * 2;
    if constexpr (!SMP) {
        auto ldp = [&](int ks, bf16x8 (&a)[2], bf16x8 (&b)[2]) {
#pragma unroll
            for (int cg = 0; cg < 2; ++cg) b[cg] = *(const LAS bf16x8*)(Ub + (16 * cg + row) * C::PU + 32 * ks + 8 * g);
#pragma unroll
            for (int mi = 0; mi < 2; ++mi) a[mi] = *(const LAS bf16x8*)(abase + (32 * ks - 16 * (2 * wave + mi)) * 2); };
        auto mmp = [&](const bf16x8 (&a)[2], const bf16x8 (&b)[2]) {
#pragma unroll
            for (int mi = 0; mi < 2; ++mi)
#pragma unroll
                for (int cg = 0; cg < 2; ++cg) acc[mi][cg] = __builtin_amdgcn_mfma_f32_16x16x32_bf16(a[mi], b[cg], acc[mi][cg], 0, 0, 0); };
        bf16x8 a0[2], b0[2], a1[2], b1[2];
        ldp(0, a0, b0);
#pragma unroll
        for (int ks = 0; ks < 8; ks += 2) { ldp(ks + 1, a1, b1); mmp(a0, b0); if (ks + 2 < 8) ldp(ks + 2, a0, b0); mmp(a1, b1); }
    } else {
        const int mt = wave;
        auto ldf = [&](int d, bf16x8 (&a)[4], bf16x8 (&b)[4]) {
            const int j = (row & 7) - d; const int brow = (j >= 0 && j < 8) ? (row & 8) + j : 16;
            const LAS bf16_t* bp = Ub + brow * C::PU + 8 * g; const LAS unsigned char* ap = abase + (-16 * mt - 128 * d) * 2;
#pragma unroll
            for (int ks = 0; ks < 4; ++ks) { a[ks] = *(const LAS bf16x8*)(ap + 64 * ks); b[ks] = *(const LAS bf16x8*)(bp + 32 * ks); } };
        bf16x8 a0[4], b0[4], a1[4], b1[4]; f32x4 accB = {0.f, 0.f, 0.f, 0.f};
        ldf(-7, a0, b0);
#pragma unroll 1
        for (int d = -7; d < 7; d += 2) {
            ldf(d + 1, a1, b1);
#pragma unroll
            for (int ks = 0; ks < 4; ++ks) acc[0][0] = __builtin_amdgcn_mfma_f32_16x16x32_bf16(a0[ks], b0[ks], acc[0][0], 0, 0, 0);
            ldf(d + 2, a0, b0);
#pragma unroll
            for (int ks = 0; ks < 4; ++ks) accB = __builtin_amdgcn_mfma_f32_16x16x32_bf16(a1[ks], b1[ks], accB, 0, 0, 0);
        }
#pragma unroll
        for (int ks = 0; ks < 4; ++ks) acc[0][0] = __builtin_amdgcn_mfma_f32_16x16x32_bf16(a0[ks], b0[ks], acc[0][0], 0, 0, 0);
        acc[0][0] += accB;
    }
}
template <bool SMP> struct HyPref {
    static constexpr int NCH = (SMP ? 16 : 32) * HyCfg<SMP>::NCHK, NIT = (NCH + NTHREADS - 1) / NTHREADS;
    float tv[2][HyCfg<SMP>::NK]; u32x4 raw[3][NIT]; unsigned hl[3][NIT], hr[3][NIT]; float sw[3][3], bias[2];
};
template <bool SMP>
__device__ __forceinline__ void hy_issue(HyPref<SMP>& p, const Ctx& F, int c) {
    typedef HyCfg<SMP> C; constexpr int L = C::L; const int tid = F.tid, lane = F.lane;
    const float* ftab = (const float*)((const unsigned char*)F.outp() + (SMP ? OUT_F1024 : OUT_F256));
#pragma unroll
    for (int ten = 0; ten < 3; ++ten)
#pragma unroll
        for (int k = 0; k < 3; ++k) p.sw[ten][k] = F.inp(I_HYSW)[k * 3072 + ten * 1024 + c];
#pragma unroll
    for (int o = 0; o < 2; ++o) { const float* fwd = ftab + (size_t)(o * 1024 + c) * L; const float* bwd = ftab + (size_t)(2048 + o * 1024 + c) * L;
        p.bias[o] = F.inp(I_HYBIAS)[o * 1024 + c];
#pragma unroll
        for (int k = 0; k < C::NK; ++k) { const int i = tid + NTHREADS * k;
            const int ia = i <= L - 1 ? L - 1 - i : (i <= 2 * L - 2 ? i - L + 1 : 0); const float* src = i <= L - 1 ? fwd : bwd;
            const float v = src[ia]; p.tv[o][k] = i <= 2 * L - 2 ? v : 0.f; } }
#pragma unroll
    for (int ten = 0; ten < 3; ++ten) {
        const bf16_t* pt = (const bf16_t*)(F.wsp() + (ten == 0 ? WS_X1T : (ten == 1 ? WS_X2T : WS_VT))) + (size_t)c * TT;
#pragma unroll
        for (int it = 0; it < HyPref<SMP>::NIT; ++it) { const int id = tid + NTHREADS * it; const int r = (id / C::NCHK) % (SMP ? 16 : 32), ci = id % C::NCHK;
            const int tseq = SMP ? (r & 7) * 128 + 8 * ci : 8 * ci;
            const size_t tok = SMP ? (size_t)TP + (size_t)(r >> 3) * LS + tseq : (size_t)r * LP + tseq;
            const bf16_t* src = pt + tok;
            p.raw[ten][it] = *(const u32x4*)src;
            p.hl[ten][it] = (unsigned)src[tseq > 0 ? -1 : 0]; p.hr[ten][it] = (unsigned)src[tseq + 8 < L ? 8 : 7]; } }
}
template <bool SMP>
__device__ __forceinline__ void hy_build(const HyPref<SMP>& p, const Ctx& F, int c) {
    typedef HyCfg<SMP> C; constexpr int L = C::L; const int tid = F.tid, lane = F.lane, wave = F.wave;
    LAS unsigned char* ft = F.lds;
    LAS bf16_t* Vb = (LAS bf16_t*)(F.lds + C::OFF_U); LAS bf16_t* X1 = Vb + C::NROW * C::PU; LAS bf16_t* X2 = X1 + C::NROW * C::PU;
    LAS float* red = (LAS float*)(F.lds + C::OFF_RED);
#pragma unroll
    for (int o = 0; o < 2; ++o) { float s = 0.f;
#pragma unroll
        for (int k = 0; k < C::NK; ++k) s += fabsf(p.tv[o][k]);
        s = wave_sum(s); if (lane == 0) red[o * 8 + wave] = s; }
#pragma unroll
    for (int ten = 0; ten < 3; ++ten) {
        const float w0 = p.sw[ten][0], w1 = p.sw[ten][1], w2 = p.sw[ten][2];
        LAS bf16_t* dst = ten == 0 ? X1 : (ten == 1 ? X2 : Vb);
#pragma unroll
        for (int it = 0; it < HyPref<SMP>::NIT; ++it) { const int id = tid + NTHREADS * it; const int r = (id / C::NCHK) % (SMP ? 16 : 32), ci = id % C::NCHK;
            const int tseq = SMP ? (r & 7) * 128 + 8 * ci : 8 * ci;
            float xc[8]; unpack8(p.raw[ten][it], xc);
            float xl = __shfl_up(xc[7], 1), xr = __shfl_down(xc[0], 1);
            if (lane == 0) xl = bf2f((bf16_t)p.hl[ten][it]); if (lane == 63) xr = bf2f((bf16_t)p.hr[ten][it]);
            if (tseq == 0) xl = 0.f; if (tseq + 8 >= L) xr = 0.f;
            float o[8];
            o[0] = w0 * xl + w1 * xc[0] + w2 * xc[1];
#pragma unroll
            for (int j = 1; j < 7; ++j) o[j] = w0 * xc[j - 1] + w1 * xc[j] + w2 * xc[j + 1];
            o[7] = w0 * xc[6] + w1 * xc[7] + w2 * xr;
            u32x4 w; w.x = pk2(o[0], o[1]); w.y = pk2(o[2], o[3]); w.z = pk2(o[4], o[5]); w.w = pk2(o[6], o[7]);
            if (id < HyPref<SMP>::NCH) *(LAS u32x4*)(dst + r * C::PU + 8 * ci) = w; } }
    if (SMP) { for (int i = tid; i < 2 * C::PU; i += NTHREADS) { if (i < C::PU) Vb[16 * C::PU + i] = 0; else X1[16 * C::PU + i - C::PU] = 0; } }
    __syncthreads();
#pragma unroll
    for (int o = 0; o < 2; ++o) { float tot = 0.f;
#pragma unroll
        for (int w = 0; w < 8; ++w) tot += red[o * 8 + w];
        const float inv = 1.0f / (tot + 1e-6f); const float bias = p.bias[o];
        LAS bf16_t* fo = (LAS bf16_t*)(ft + o * 8 * C::CP) + 8;
#pragma unroll
        for (int k = 0; k < C::NK; ++k) { const int i = tid + NTHREADS * k;
            if (i < C::NTAP) { const bf16_t w = (bf16_t)f2bf(p.tv[o][k] * inv + (i == L - 1 ? bias : 0.f));
#pragma unroll
                for (int m = 0; m < 8; ++m) fo[m * (C::CP / 2) + i - m] = w; } } }
    __syncthreads();
}
template <bool SMP>
__device__ __forceinline__ void hy_compute(const Ctx& F, unsigned long long (&yb)[SMP ? 4 : 16]) {
    typedef HyCfg<SMP> C; const int lane = F.lane, wave = F.wave;
    LAS unsigned char* ft = F.lds;
    LAS bf16_t* Vb = (LAS bf16_t*)(F.lds + C::OFF_U); LAS bf16_t* X1 = Vb + C::NROW * C::PU; LAS bf16_t* X2 = X1 + C::NROW * C::PU;
    const int n = lane & 15, g = lane >> 4;
    constexpr int NMI = SMP ? 1 : 2, NCG = SMP ? 1 : 2;
    { f32x4 acc[2][2]; acc[0][0] = acc[0][1] = acc[1][0] = acc[1][1] = (f32x4){0.f, 0.f, 0.f, 0.f};
      hy_conv<SMP>(acc, ft, Vb, wave, lane);
#pragma unroll
      for (int mi = 0; mi < NMI; ++mi)
#pragma unroll
          for (int cg = 0; cg < NCG; ++cg) { const int mt = SMP ? wave : 2 * wave + mi; LAS bf16_t* p = X1 + (16 * cg + n) * C::PU + 16 * mt + 4 * g;
              const u32x2 xv = *(const LAS u32x2*)p; u32x2 w; w.x = pk2(bflo(xv.x) * acc[mi][cg][0], bfhi(xv.x) * acc[mi][cg][1]); w.y = pk2(bflo(xv.y) * acc[mi][cg][2], bfhi(xv.y) * acc[mi][cg][3]);
              *(LAS u32x2*)p = w; } }
    __syncthreads();
    { f32x4 acc[2][2]; acc[0][0] = acc[0][1] = acc[1][0] = acc[1][1] = (f32x4){0.f, 0.f, 0.f, 0.f};
      hy_conv<SMP>(acc, ft + 8 * C::CP, X1, wave, lane);
#pragma unroll
      for (int mi = 0; mi < NMI; ++mi)
#pragma unroll
          for (int cg = 0; cg < NCG; ++cg) { const int mt = SMP ? wave : 2 * wave + mi; const int tl = 16 * mt + 4 * g;
              const u32x2 xv = *(const LAS u32x2*)(X2 + (16 * cg + n) * C::PU + tl);
              const float y[4] = {bflo(xv.x) * acc[mi][cg][0], bfhi(xv.x) * acc[mi][cg][1], bflo(xv.y) * acc[mi][cg][2], bfhi(xv.y) * acc[mi][cg][3]};
#pragma unroll
              for (int e = 0; e < 4; ++e) { unsigned long long& q = yb[(mi * NCG + cg) * 4 + e]; q = (q >> 16) | ((unsigned long long)f2bf(y[e]) << 48); } } }
    __syncthreads();
}
template <bool SMP>
__device__ __forceinline__ void hy_store(const Ctx& F, const unsigned long long (&yb)[SMP ? 4 : 16], int c0) {
    const int lane = F.lane, wave = F.wave, n = lane & 15, g = lane >> 4;
    constexpr int NMI = SMP ? 1 : 2, NCG = SMP ? 1 : 2;
    bf16_t* Y = (bf16_t*)(F.wsp() + WS_R1);
#pragma unroll
    for (int mi = 0; mi < NMI; ++mi)
#pragma unroll
        for (int cg = 0; cg < NCG; ++cg) { const int mt = SMP ? wave : 2 * wave + mi; const int tl = 16 * mt + 4 * g;
            const size_t tok = SMP ? (size_t)TP + (size_t)(n >> 3) * LS + (n & 7) * 128 + tl : (size_t)(16 * cg + n) * LP + tl;
#pragma unroll
            for (int e = 0; e < 4; ++e) *(unsigned long long*)(Y + (tok + e) * DHY + c0) = yb[(mi * NCG + cg) * 4 + e]; }
}
template <bool SMP>
__device__ __forceinline__ void hyena_items(const Ctx& F0) {
    const Ctx F = fresh(F0);
    HyPref<SMP> p0, p1; unsigned long long yb[SMP ? 4 : 16];
#pragma unroll 1
    for (int c0 = 4 * F.vcu; c0 < DHY; c0 += 4 * F.G) {
        hy_issue<SMP>(p0, F, c0); hy_issue<SMP>(p1, F, c0 + 1);
        hy_build<SMP>(p0, F, c0);     hy_issue<SMP>(p0, F, c0 + 2); hy_compute<SMP>(F, yb);
        hy_build<SMP>(p1, F, c0 + 1); hy_issue<SMP>(p1, F, c0 + 3); hy_compute<SMP>(F, yb);
        hy_build<SMP>(p0, F, c0 + 2); hy_compute<SMP>(F, yb);
        hy_build<SMP>(p1, F, c0 + 3); hy_compute<SMP>(F, yb);
        { const Ctx Fq = fresh(F0); hy_store<SMP>(Fq, yb, c0); }
    }
}

__device__ __forceinline__ void phase_D(const Ctx& F) {
    for (int v = F.vcu; v < 256; v += F.G) {
        RetPref pf;
        if (v < 128) { const int bg = 32 + (v >> 6), h = (v >> 3) & 7, qt = v & 7; ret_issue(pf, F, bg, h, qt); ret_item(F, pf, bg, h, qt, false, 0, 0, 0); }
        else { const int j0 = 4 * (v - 128); ret_issue(pf, F, j0 >> 4, (j0 >> 1) & 7, j0 & 1);
#pragma unroll 1
            for (int k = 0; k < 4; ++k) { const int j = j0 + k, jn = j + 1; ret_item(F, pf, j >> 4, (j >> 1) & 7, j & 1, k < 3, jn >> 4, (jn >> 1) & 7, jn & 1); } }
    }
    if (F.G == 256) { if (F.vcu < 128) { for (int k = 0; k < 2; ++k) { const int j = 2 * F.vcu + k; state_item(F, j >> 3, j & 7); __syncthreads(); } } }
    else for (int j = F.vcu; j < 256; j += F.G) { state_item(F, j >> 3, j & 7); __syncthreads(); }
    hyena_items<true>(F);
    hyena_items<false>(F);
}

__device__ __forceinline__ void phase_G(const Ctx& F) {
    LAS float* Gm = (LAS float*)F.lds; LAS float* Af = Gm + 3 * DM; LAS float* Bf = Af + 3 * DM;
    { const float* mc = (const float*)(F.wsp() + WS_MODC);
      for (int i = F.tid; i < 3 * DM; i += NTHREADS) { const int mv = i >> 11, c = i & 2047; Gm[i] = mc[(mv * 6 + MC_GM) * DM + c]; Af[i] = mc[(mv * 6 + MC_AF) * DM + c]; Bf[i] = mc[(mv * 6 + MC_BF) * DM + c]; } }
    __syncthreads();
    const int gw = F.vcu * NWAVES + F.wave, NGW = F.G * NWAVES;
    const bf16_t* M = (const bf16_t*)(F.wsp() + WS_PROJ); bf16_t* H2 = (bf16_t*)(F.wsp() + WS_R1);
    for (int r = gw; r < TT; r += NGW) {
        const int mv = row_mv(r); const u32x2* mr = (const u32x2*)(M + (size_t)r * DM) + F.lane; const f32x4* xr = (const f32x4*)x_row(F, r) + F.lane;
        f32x4 v[8], xv[8]; float ss = 0.f;
#pragma unroll
        for (int j = 0; j < 8; ++j) xv[j] = xr[64 * j];
        if (r >= TP) { const u32x2* sp = mr + ((size_t)TT * DM - (size_t)TP * DM) / 4;
            u32x2 q0[8], q1[8], q2[8], q3[8];
#pragma unroll
            for (int j = 0; j < 8; ++j) { q0[j] = mr[64 * j]; q1[j] = sp[64 * j]; q2[j] = sp[64 * j + (size_t)TSM * DM / 4]; q3[j] = sp[64 * j + 2 * (size_t)TSM * DM / 4]; }
#pragma unroll
            for (int j = 0; j < 8; ++j) v[j] = (bf4(q0[j]) + bf4(q1[j])) + (bf4(q2[j]) + bf4(q3[j]));
        } else { u32x2 q0[8];
#pragma unroll
            for (int j = 0; j < 8; ++j) q0[j] = mr[64 * j];
#pragma unroll
            for (int j = 0; j < 8; ++j) v[j] = bf4(q0[j]); }
#pragma unroll
        for (int j = 0; j < 8; ++j) ss += (v[j].x * v[j].x + v[j].y * v[j].y) + (v[j].z * v[j].z + v[j].w * v[j].w);
        const float rstd = rsqrtf(wave_sum(ss) * (1.0f / DM) + 1e-6f); float s1 = 0.f;
        u32x2* xo = (u32x2*)((bf16_t*)(F.wsp() + WS_R2) + (size_t)r * DM) + F.lane;
#pragma unroll
        for (int j = 0; j < 8; ++j) { const int c = 4 * F.lane + 256 * j; const f32x4 g = *(const LAS f32x4*)(Gm + mv * DM + c);
            const f32x4 x1 = xv[j] + g * (v[j] * rstd); v[j] = x1; s1 += (x1.x * x1.x + x1.y * x1.y) + (x1.z * x1.z + x1.w * x1.w); }
#pragma unroll
        for (int j = 0; j < 8; ++j) { u32x2 w; w.x = pk2(v[j].x, v[j].y); w.y = pk2(v[j].z, v[j].w); xo[64 * j] = w; }
        const float rstd1 = rsqrtf(wave_sum(s1) * (1.0f / DM) + 1e-6f);
        u32x2* o = (u32x2*)(H2 + (size_t)r * DM) + F.lane;
#pragma unroll
        for (int j = 0; j < 8; ++j) { const int c = 4 * F.lane + 256 * j; const f32x4 a = *(const LAS f32x4*)(Af + mv * DM + c), b = *(const LAS f32x4*)(Bf + mv * DM + c);
            const f32x4 h = v[j] * rstd1 * a + b; u32x2 w; w.x = pk2(h.x, h.y); w.y = pk2(h.z, h.w); o[64 * j] = w; }
    }
    __syncthreads();
}

__device__ __forceinline__ void phase_I(const Ctx& F) {
    const bf16_t* UE = (const bf16_t*)(F.wsp() + WS_UE); bf16_t* ACT = (bf16_t*)(F.wsp() + WS_ACT2); const float* cw = F.inp(I_FFNCONV);
    const int gid = F.vcu * NTHREADS + F.tid, nth = F.G * NTHREADS;
    constexpr int NCG = DFF / 8, NROWS = (TT / 256) * 8, NTASK = NROWS * NCG;
    for (int task = gid; task < NTASK; task += nth) {
        const int ri = task / NCG, cg = task - ri * NCG, c0 = cg * 8;
        const int pm = ri >> 3, strip = (ri >> 1) & 3, e = ri & 1;
        const int r = 64 * strip + (e ? 63 : 0), g = pm * 256 + r;
        const bool smp = g >= TP; const int t = smp ? ((g - TP) & (LS - 1)) : r; const int L = smp ? LS : LP;
        auto ue = [&](int tile, int st, int w, int ab) { return UE + ((size_t)((tile * 4 + st) * 4 + w) * 2 + ab) * DFF + c0; };
        float am[8], ac[8], ap[8], bm[8], bc[8], bp[8];
        unpack8(*(const u32x4*)ue(pm, strip, e ? 3 : 0, 0), ac); unpack8(*(const u32x4*)ue(pm, strip, e ? 3 : 0, 1), bc);
        if (e) { unpack8(*(const u32x4*)ue(pm, strip, 2, 0), am); unpack8(*(const u32x4*)ue(pm, strip, 2, 1), bm); }
        else if (t > 0) { const int tp = strip > 0 ? pm : pm - 1, sp = strip > 0 ? strip - 1 : 3; unpack8(*(const u32x4*)ue(tp, sp, 3, 0), am); unpack8(*(const u32x4*)ue(tp, sp, 3, 1), bm); }
        else {
#pragma unroll
            for (int j = 0; j < 8; ++j) { am[j] = 0.f; bm[j] = 0.f; } }
        if (!e) { unpack8(*(const u32x4*)ue(pm, strip, 1, 0), ap); unpack8(*(const u32x4*)ue(pm, strip, 1, 1), bp); }
        else if (t + 1 < L) { const int tn = strip < 3 ? pm : pm + 1, sn = strip < 3 ? strip + 1 : 0; unpack8(*(const u32x4*)ue(tn, sn, 0, 0), ap); unpack8(*(const u32x4*)ue(tn, sn, 0, 1), bp); }
        else {
#pragma unroll
            for (int j = 0; j < 8; ++j) { ap[j] = 0.f; bp[j] = 0.f; } }
        float wa[3][8], wb[3][8];
#pragma unroll
        for (int k = 0; k < 3; ++k) { const f32x4 a0 = *(const f32x4*)(cw + k * NIN + c0), a1 = *(const f32x4*)(cw + k * NIN + c0 + 4), b0 = *(const f32x4*)(cw + k * NIN + DFF + c0), b1 = *(const f32x4*)(cw + k * NIN + DFF + c0 + 4);
            wa[k][0] = a0.x; wa[k][1] = a0.y; wa[k][2] = a0.z; wa[k][3] = a0.w; wa[k][4] = a1.x; wa[k][5] = a1.y; wa[k][6] = a1.z; wa[k][7] = a1.w;
            wb[k][0] = b0.x; wb[k][1] = b0.y; wb[k][2] = b0.z; wb[k][3] = b0.w; wb[k][4] = b1.x; wb[k][5] = b1.y; wb[k][6] = b1.z; wb[k][7] = b1.w; }
        float o[8];
#pragma unroll
        for (int j = 0; j < 8; ++j) { const float a = wa[0][j] * am[j] + wa[1][j] * ac[j] + wa[2][j] * ap[j]; const float b = wb[0][j] * bm[j] + wb[1][j] * bc[j] + wb[2][j] * bp[j]; o[j] = pg8::gelu_gate(a, b); }
        u32x4 w; w.x = pk2(o[0], o[1]); w.y = pk2(o[2], o[3]); w.z = pk2(o[4], o[5]); w.w = pk2(o[6], o[7]);
        *(u32x4*)(ACT + (size_t)g * DFF + c0) = w;
    }
}

__device__ __forceinline__ void phase_K(const Ctx& F) {
    LAS float* Gf = (LAS float*)F.lds;
    { const float* mc = (const float*)(F.wsp() + WS_MODC);
      for (int i = F.tid; i < 3 * DM; i += NTHREADS) { const int mv = i >> 11, c = i & 2047; Gf[i] = mc[(mv * 6 + MC_GF) * DM + c]; } }
    __syncthreads();
    const int gw = F.vcu * NWAVES + F.wave, NGW = F.G * NWAVES;
    const bf16_t* Fb = (const bf16_t*)(F.wsp() + WS_FSLAB);
    for (int r = gw; r < TT; r += NGW) {
        const int mv = row_mv(r); const u32x2* fr = (const u32x2*)(Fb + (size_t)r * DM) + F.lane;
        f32x4 v[8]; float ss = 0.f;
        if (r >= TP) { const u32x2* sp = fr + ((size_t)TT * DM - (size_t)TP * DM) / 4;
            u32x2 q0[8], q1[8], q2[8], q3[8];
#pragma unroll
            for (int j = 0; j < 8; ++j) { q0[j] = fr[64 * j]; q1[j] = sp[64 * j]; q2[j] = sp[64 * j + (size_t)TSM * DM / 4]; q3[j] = sp[64 * j + 2 * (size_t)TSM * DM / 4]; }
#pragma unroll
            for (int j = 0; j < 8; ++j) v[j] = (bf4(q0[j]) + bf4(q1[j])) + (bf4(q2[j]) + bf4(q3[j]));
        } else { u32x2 q0[8];
#pragma unroll
            for (int j = 0; j < 8; ++j) q0[j] = fr[64 * j];
#pragma unroll
            for (int j = 0; j < 8; ++j) v[j] = bf4(q0[j]); }
#pragma unroll
        for (int j = 0; j < 8; ++j) ss += (v[j].x * v[j].x + v[j].y * v[j].y) + (v[j].z * v[j].z + v[j].w * v[j].w);
        const float rstd = rsqrtf(wave_sum(ss) * (1.0f / DM) + 1e-6f);
        f32x4* xo = (f32x4*)(F.outp() + (size_t)r * DM) + F.lane; f32x4 xv[8];
        const u32x2* x1r = (const u32x2*)((const bf16_t*)(F.wsp() + WS_R2) + (size_t)r * DM) + F.lane;
#pragma unroll
        for (int j = 0; j < 8; ++j) xv[j] = bf4(x1r[64 * j]);
#pragma unroll
        for (int j = 0; j < 8; ++j) { const int c = 4 * F.lane + 256 * j; const f32x4 g = *(const LAS f32x4*)(Gf + mv * DM + c); xv[j] = xv[j] + g * (v[j] * rstd); }
#pragma unroll
        for (int j = 0; j < 8; ++j) xo[64 * j] = xv[j];
    }
}

constexpr int N_PHASES = 11;
template <int LO, int HI>
__global__ void __launch_bounds__(NTHREADS, 2) hyret_fwd(Args args) {
    extern __shared__ __attribute__((aligned(16))) unsigned char lds_raw[];
    Ctx F;
    F.lds = (LAS unsigned char*)lds_raw; F.tid = threadIdx.x; F.lane = F.tid & 63; F.wave = __builtin_amdgcn_readfirstlane(F.tid >> 6);
    F.G = gridDim.x; { const int bx = blockIdx.x; F.vcu = (F.G % 8 == 0) ? (bx % 8) * (F.G / 8) + bx / 8 : bx; }
    F.in_ = args.in; F.out_ = args.out; F.ws_ = args.ws;
    volatile LAS unsigned* MISC = (volatile LAS unsigned*)(F.lds + LDS_MISC);
    if (F.tid < 64) MISC[F.tid] = 0u;
    __syncthreads();
    constexpr int lo = LO, hi = HI;
    XcdBarrier bar; bar.bar = (unsigned*)(F.wsp() + WS_CTL) + CW_BAR + args.li * XCD_BAR_WORDS; bar.x = 0; bar.st = nullptr;
    if constexpr (hi - lo > 1) bar = xcd_barrier_post((unsigned*)(F.wsp() + WS_CTL) + CW_BAR + args.li * XCD_BAR_WORDS, MISC + 8);
#define IN(k) (lo <= (k) && (k) < hi)
#define SEAM(k) do { if constexpr (IN(k) && IN((k) + 1)) xcd_barrier(bar); } while (0)

#define BODY_0  { const Ctx P = phase_ctx(F); phase_A(P); }
#define BODY_1  { const Ctx P = phase_ctx(F); phase_B(P); }
#define BODY_2  { const Ctx P = phase_ctx(F);   \
        { pg8::Gemm g; g.A0 = g.A1 = (const bf16_t*)(P.wsp() + WS_R1); g.B0 = g.B1 = (const bf16_t*)((const unsigned char*)P.outp() + OUT_WIN); g.M = TT; g.N = 3072; g.K = DM; \
          pg8::Order S; S.init(TT, 3072, DM, P.G, (int)blockIdx.x, 1); \
          pg8::EpiHyT E{(bf16_t*)(P.wsp() + WS_X1T), (bf16_t*)(P.wsp() + WS_X2T), (bf16_t*)(P.wsp() + WS_VT)}; \
          pg8::gemm_phase<pg8::EpiHyT, pg8::Order>(P.lds, g, S, E); } \
        { pg8::Gemm g; g.A0 = g.A1 = (const bf16_t*)(P.wsp() + WS_R1); g.B0 = g.B1 = (const bf16_t*)((const unsigned char*)P.outp() + OUT_WIN) + (size_t)3072 * DM; g.M = TT; g.N = NPJ; g.K = DM; \
          pg8::Order S; S.init(TT, NPJ, DM, P.G, (int)blockIdx.x, 1); \
          pg8::EpiProj E{(bf16_t*)(P.wsp() + WS_PROJ), PJP, (bf16_t*)(P.wsp() + WS_GATE)}; \
          pg8::gemm_phase<pg8::EpiProj, pg8::Order>(P.lds, g, S, E); } }
#define BODY_3  { const Ctx P = phase_ctx(F); phase_D(P); }
#define BODY_4  { const Ctx P = phase_ctx(F);   \
        pg8::Gemm g; g.A0 = (const bf16_t*)(P.wsp() + WS_R1); g.A1 = (const bf16_t*)(P.wsp() + WS_R1) + (size_t)TT * DHY; g.B0 = (const bf16_t*)(P.wsp() + WS_WBRH); g.B1 = (const bf16_t*)(P.wsp() + WS_WBRR); g.M = TT; g.N = DM; g.K = DHY; \
        pg8::Order S; S.init(TT, DM, DHY, P.G, (int)blockIdx.x, 2); S.vc2 = P.vcu; \
        pg8::EpiMerge E{(bf16_t*)(P.wsp() + WS_R2), (const bf16_t*)(P.wsp() + WS_GATE)}; \
        pg8::gemm_phase<pg8::EpiMerge, pg8::Order>(P.lds, g, S, E); \
        { const int n2 = (TT / 256) * (DM / 256) - P.G;        \
          if (n2 < 0 || n2 >= P.G) late_transposes(P, P.vcu, P.G); else if (P.vcu >= n2) late_transposes(P, P.vcu - n2, P.G - n2); } }
#define BODY_5  { const Ctx P = phase_ctx(F);   \
        pg8::Gemm g; g.A0 = g.A1 = (const bf16_t*)(P.wsp() + WS_R2); g.B0 = g.B1 = (const bf16_t*)(P.wsp() + WS_WOUT); g.M = TT; g.N = DM; g.K = DM; \
        pg8::TwoRoundOrder S; S.init(TT, DM, DM, P.G, P.vcu); \
        pg8::EpiBf16 E{(bf16_t*)(P.wsp() + WS_PROJ), DM, (size_t)TT * DM}; \
        pg8::gemm_phase<pg8::EpiBf16, pg8::TwoRoundOrder>(P.lds, g, S, E); }
#define BODY_6  { const Ctx P = phase_ctx(F); phase_G(P); }
#define BODY_7  { const Ctx P = phase_ctx(F);   \
        pg8::Gemm g; g.A0 = g.A1 = (const bf16_t*)(P.wsp() + WS_R1); g.B0 = g.B1 = (const bf16_t*)(P.wsp() + WS_WUP); g.M = TT; g.N = NIN; g.K = DM; \
        pg8::Order S; S.init(TT, NIN, DM, P.G, (int)blockIdx.x, 1); \
        pg8::EpiGate E{(bf16_t*)(P.wsp() + WS_ACT2), (bf16_t*)(P.wsp() + WS_UE), P.inp(I_FFNCONV)}; \
        pg8::gemm_phase<pg8::EpiGate, pg8::Order>(P.lds, g, S, E); }
#define BODY_8  { const Ctx P = phase_ctx(F); phase_I(P); }
#define BODY_9  { const Ctx P = phase_ctx(F);   \
        pg8::Gemm g; g.A0 = g.A1 = (const bf16_t*)(P.wsp() + WS_ACT2); g.B0 = g.B1 = (const bf16_t*)(P.wsp() + WS_WDOWN); g.M = TT; g.N = DM; g.K = DFF; \
        pg8::TwoRoundOrder S; S.init(TT, DM, DFF, P.G, P.vcu); \
        pg8::EpiBf16 E{(bf16_t*)(P.wsp() + WS_FSLAB), DM, (size_t)TT * DM}; \
        pg8::gemm_phase<pg8::EpiBf16, pg8::TwoRoundOrder>(P.lds, g, S, E); }
#define BODY_10  { const Ctx P = phase_ctx(F); phase_K(P); }
    if constexpr (IN(0)) { BODY_0 }
    if constexpr (IN(1)) { BODY_1 } SEAM(1);
    if constexpr (IN(2)) { BODY_2 } SEAM(2);
    if constexpr (IN(3)) { BODY_3 } SEAM(3);
    if constexpr (IN(4)) { BODY_4 } SEAM(4);
    if constexpr (IN(5)) { BODY_5 } SEAM(5);
    if constexpr (IN(6)) { BODY_6 } SEAM(6);
    if constexpr (IN(7)) { BODY_7 } SEAM(7);
    if constexpr (IN(8)) { BODY_8 } SEAM(8);
    if constexpr (IN(9)) { BODY_9 } SEAM(9);
    if constexpr (IN(10)) { BODY_10 }
#undef IN
#undef SEAM
}

typedef void (*kern_t)(Args);
template <int PH> static kern_t phase_kernel() { return hyret_fwd<PH, PH + 1>; }
extern "C" void kernel_launch(void* const* d_in, const int* in_sizes, int n_in, void* d_out, int out_size, void* d_ws, size_t ws_size, hipStream_t stream) {
    static int grid = 0;
#if MK_N_LAUNCHES == 1
    static const kern_t kerns[1] = {hyret_fwd<0, N_PHASES>};
    constexpr int NK = 1;
#else
    static const kern_t kerns[N_PHASES] = {phase_kernel<0>(), phase_kernel<1>(), phase_kernel<2>(), phase_kernel<3>(), phase_kernel<4>(), phase_kernel<5>(),
                                           phase_kernel<6>(), phase_kernel<7>(), phase_kernel<8>(), phase_kernel<9>(), phase_kernel<10>()};
    constexpr int NK = N_PHASES;
#endif
    if (grid == 0) {
        if (n_in != 30 || ws_size < WS_END) { fprintf(stderr, "kernel_launch: need 30 inputs and >= %zu bytes of workspace; got n_in %d ws %zu\n", (size_t)WS_END, n_in, ws_size); grid = -1; return; }
        int dev = 0, cus = 0, per_cu = 0;
        if (hipGetDevice(&dev) != hipSuccess || hipDeviceGetAttribute(&cus, hipDeviceAttributeMultiprocessorCount, dev) != hipSuccess) { grid = -1; return; }
        for (int k = 0; k < NK; ++k) {
            if (hipFuncSetAttribute((const void*)kerns[k], hipFuncAttributeMaxDynamicSharedMemorySize, LDS_BYTES) != hipSuccess) { fprintf(stderr, "kernel_launch: hipFuncSetAttribute failed\n"); grid = -1; return; }
            if (hipOccupancyMaxActiveBlocksPerMultiprocessor(&per_cu, (const void*)kerns[k], NTHREADS, LDS_BYTES) != hipSuccess || per_cu < 1) { fprintf(stderr, "kernel_launch: occupancy query says %d blocks per CU for kernel %d\n", per_cu, k); }
        }
        (void)hipGetLastError();
        if (cus != 256) { fprintf(stderr, "kernel_launch: built for a 256-CU device (work decomposition), found %d CUs; nothing launched\n", cus); grid = -1; return; }
        grid = cus;
    }
    if (grid < 0) return;
    (void)hipMemsetAsync((char*)d_ws + WS_CTL, 0, CTL_ZERO_BYTES, stream);
    Args a{};
    for (int i = 0; i < 30; ++i) a.in[i] = (const GAS float*)d_in[i];
    a.out = (GAS float*)d_out; a.ws = (GAS unsigned char*)d_ws;
    for (int k = 0; k < NK; ++k) { a.ph_lo = 0; a.ph_hi = 0; a.li = 0; hipLaunchKernelGGL(kerns[k], dim3(grid), dim3(NTHREADS), LDS_BYTES, stream, a); }
}
```
